# Optimizing an MI355X kernel written in HIP

```python
import math
import jax, jax.numpy as jnp
from jax import lax
import numpy as np

D_MODEL = 1024
BATCH = 8
SEQ = 4096
DEPTH = 1

DA_HEADS = 4
DA_HEAD_DIM = 64
DA_V_DIM = 2 * DA_HEAD_DIM
DA_WIDTH = DA_HEADS * DA_V_DIM
QK_WIDTH = DA_HEADS * 2 * DA_HEAD_DIM
FT_GROUPS = 4
FT_GROUP_DIM = 128
FT_WIDTH = FT_GROUPS * FT_GROUP_DIM
MIX_WIDTH = DA_WIDTH + FT_WIDTH
IN_PROJ_WIDTH = 2 * QK_WIDTH + DA_WIDTH + FT_WIDTH
D_FF = 2816
CONV_WIDTH = 3
Q_BLOCK = 128
EPS = 1e-6
SUBLN_EPS = 1e-5

kernel_name = "hybrid_diffattn_fnet_convffn_encoder"


def rmsnorm(x, g, eps=EPS):
    xf = x.astype(jnp.float32)
    y = xf * lax.rsqrt(jnp.mean(xf * xf, axis=-1, keepdims=True) + eps) * g.astype(jnp.float32)
    return y.astype(x.dtype)


def alibi_slopes(n_heads):
    return jnp.array([2.0 ** (-8.0 * (h + 1) / n_heads) for h in range(n_heads)], dtype=jnp.float32)


def diff_attention(q, k, v, lam, slopes):
    B, S = q.shape[0], q.shape[1]
    nb = S // Q_BLOCK
    scale = DA_HEAD_DIM ** -0.5
    qb = q.reshape(B, nb, Q_BLOCK, DA_HEADS, 2, DA_HEAD_DIM).transpose(1, 0, 2, 3, 4, 5)
    pos_k = jnp.arange(S, dtype=jnp.int32)

    def block(args):
        qi, i = args
        pos_q = i * Q_BLOCK + jnp.arange(Q_BLOCK, dtype=jnp.int32)
        dist = jnp.abs(pos_q[:, None] - pos_k[None, :]).astype(jnp.float32)
        s = jnp.einsum('bqhcd,bkhcd->bhcqk', qi, k,
                       preferred_element_type=jnp.float32) * scale
        s = s - slopes[None, :, None, None, None] * dist[None, None, None]
        p = jax.nn.softmax(s, axis=-1)
        a = p[:, :, 0] - lam * p[:, :, 1]
        return jnp.einsum('bhqk,bkhv->bqhv', a.astype(v.dtype), v)

    o = lax.map(block, (qb, jnp.arange(nb, dtype=jnp.int32)))
    return o.transpose(1, 0, 2, 3, 4).reshape(B, S, DA_HEADS, DA_V_DIM)


def fourier_mix(u, w_ft):
    B, S = u.shape[0], u.shape[1]
    ug = u.reshape(B, S, FT_GROUPS, FT_GROUP_DIM).astype(jnp.float32)
    f = jnp.fft.fft2(ug, axes=(1, 3), norm="ortho").real
    out = jnp.einsum('bsgc,gcd->bsgd', f.astype(u.dtype), w_ft)
    return out.reshape(B, S, FT_WIDTH)


def centred_dwconv(h, w_conv, b_conv):
    hp = jnp.pad(h, ((0, 0), (1, 1), (0, 0)))
    return (w_conv[0] * hp[:, :-2] + w_conv[1] * hp[:, 1:-1] + w_conv[2] * hp[:, 2:] + b_conv)


def setup_inputs(seed: int = 0) -> dict:
    key = jax.random.key(seed)
    ks = jax.random.split(key, 16)
    f32 = jnp.float32
    nrm = lambda k, shape, s: (jax.random.normal(k, shape, f32) * s)
    return {
        "x": jax.random.normal(ks[0], (BATCH, SEQ, D_MODEL), f32),
        "g_mix": 1.0 + nrm(ks[1], (DEPTH, D_MODEL), 0.02),
        "w_in": nrm(ks[2], (DEPTH, D_MODEL, IN_PROJ_WIDTH), D_MODEL ** -0.5),
        "lambda_q1": nrm(ks[3], (DEPTH, DA_HEAD_DIM), 0.1),
        "lambda_k1": nrm(ks[4], (DEPTH, DA_HEAD_DIM), 0.1),
        "lambda_q2": nrm(ks[5], (DEPTH, DA_HEAD_DIM), 0.1),
        "lambda_k2": nrm(ks[6], (DEPTH, DA_HEAD_DIM), 0.1),
        "g_subln": 1.0 + nrm(ks[7], (DEPTH, DA_V_DIM), 0.02),
        "w_ft": nrm(ks[8], (DEPTH, FT_GROUPS, FT_GROUP_DIM, FT_GROUP_DIM), FT_GROUP_DIM ** -0.5),
        "w_out": nrm(ks[9], (DEPTH, MIX_WIDTH, D_MODEL), MIX_WIDTH ** -0.5),
        "g_ffn": 1.0 + nrm(ks[10], (DEPTH, D_MODEL), 0.02),
        "w_up": nrm(ks[11], (DEPTH, D_MODEL, 2 * D_FF), D_MODEL ** -0.5),
        "w_conv": nrm(ks[12], (DEPTH, CONV_WIDTH, 2 * D_FF), CONV_WIDTH ** -0.5),
        "b_conv": nrm(ks[13], (DEPTH, 2 * D_FF), 0.01),
        "w_down": nrm(ks[14], (DEPTH, D_FF, D_MODEL), D_FF ** -0.5),
        "g_final": 1.0 + nrm(ks[15], (D_MODEL,), 0.02),
    }


def reference(x, g_mix, w_in, lambda_q1, lambda_k1, lambda_q2, lambda_k2, g_subln, w_ft,
              w_out, g_ffn, w_up, w_conv, b_conv, w_down, g_final):
    B, S = x.shape[0], x.shape[1]
    slopes = alibi_slopes(DA_HEADS)
    for l in range(DEPTH):
        lambda_init = 0.8 - 0.6 * math.exp(-0.3 * l)
        h = rmsnorm(x, g_mix[l])
        z = h @ w_in[l]
        q = z[..., :QK_WIDTH].reshape(B, S, DA_HEADS, 2, DA_HEAD_DIM)
        k = z[..., QK_WIDTH:2 * QK_WIDTH].reshape(B, S, DA_HEADS, 2, DA_HEAD_DIM)
        v = z[..., 2 * QK_WIDTH:2 * QK_WIDTH + DA_WIDTH].reshape(B, S, DA_HEADS, DA_V_DIM)
        u = z[..., 2 * QK_WIDTH + DA_WIDTH:]
        lam = (jnp.exp(jnp.sum(lambda_q1[l].astype(jnp.float32) * lambda_k1[l].astype(jnp.float32)))
               - jnp.exp(jnp.sum(lambda_q2[l].astype(jnp.float32) * lambda_k2[l].astype(jnp.float32)))
               + lambda_init)
        o_da = diff_attention(q, k, v, lam, slopes)
        o_da = rmsnorm(o_da, g_subln[l], SUBLN_EPS) * (1.0 - lambda_init)
        o_ft = fourier_mix(u, w_ft[l])
        mixed = jnp.concatenate([o_da.reshape(B, S, DA_WIDTH), o_ft], axis=-1)
        x = x + mixed @ w_out[l]
        h = rmsnorm(x, g_ffn[l])
        up = centred_dwconv(h @ w_up[l], w_conv[l], b_conv[l])
        gate, val = up[..., :D_FF], up[..., D_FF:]
        x = x + (jax.nn.silu(gate) * val) @ w_down[l]
    return rmsnorm(x, g_final)
```

```cpp
#include <hip/hip_runtime.h>
#include <hip/hip_cooperative_groups.h>
#include <cstdio>
#include <cstdint>
namespace cg = cooperative_groups;
#ifndef ABL_FFN
#define ABL_FFN 1.0f
#endif
#ifndef ABL_ATT
#define ABL_ATT 1.0f
#endif
#ifndef ABL_FT
#define ABL_FT 1.0f
#endif
namespace pg8 {
#define PG8_LAS __attribute__((address_space(3)))
typedef unsigned short bf16_t;
typedef short bf16x8 __attribute__((ext_vector_type(8)));
typedef float f32x4 __attribute__((ext_vector_type(4)));
typedef unsigned u32x4 __attribute__((ext_vector_type(4)));
constexpr int BM = 256, BK = 64, HALF = 128, HTB = HALF * BK * 2  , STAGE_BYTES = 8 * HTB, NXCD = 8, WGM = 8;

__host__ __device__ __forceinline__ int lds_byte(int r, int c) { const int st = (r >> 4) * 2 + (c >> 5), rr = r & 15, cc = c & 31, ob = rr * 64 + cc * 2; return st * 1024 + (ob ^ (((ob >> 9) & 1) << 5)); }
__host__ __device__ __forceinline__ void stage_rc(int b, int& R, int& C) { const int st = b / 1024, sb = b % 1024, swz = sb ^ (((sb >> 9) & 1) << 5); R = (st >> 1) * 16 + swz / 64; C = (st & 1) * 32 + (swz % 64) / 2; }
__host__ __device__ __forceinline__ int perm32(int rho) { const int n = rho >> 4, i = rho & 15; return 8 * (i >> 2) + 4 * n + (i & 3); }

struct Unit { int pm, pn; };
struct Gemm { const bf16_t* A; const bf16_t* Bt; int M, N, K; };

struct StaticOrder {
    int nM, nN, nwg, G, c;
    __host__ __device__ void init(int M, int N, int G_, int c_) { nM = M / BM; nN = N / BM; nwg = nM * nN; G = G_; c = c_; }
    __host__ __device__ bool next(int i, Unit& u) const {
        const long L = (long)i * G + c; if (L >= nwg) return false;
        int wgid = (int)L; { const int q = nwg / NXCD, r = nwg % NXCD, xcd = wgid % NXCD, off = wgid / NXCD; wgid = (xcd < r ? xcd * (q + 1) : r * (q + 1) + (xcd - r) * q) + off; }
        const int nig = WGM * nN, gid = wgid / nig, fm = gid * WGM, gsz = (nM - fm) < WGM ? (nM - fm) : WGM;
        u.pm = fm + ((wgid % nig) % gsz); u.pn = (wgid % nig) / gsz; return true;
    }
    __device__ __forceinline__ void a_ready(const Unit&) const {}
    __device__ __forceinline__ void done(const Unit&) const {}
};

__device__ __forceinline__ unsigned cvt_pk_bf16(float lo, float hi) { unsigned r; asm volatile("v_cvt_pk_bf16_f32 %0, %1, %2" : "=v"(r) : "v"(lo), "v"(hi)); return r; }

template <int K> __device__ __forceinline__ float xsum(float v) {
    if constexpr (K == 32) { float a = v, b = v;
        asm volatile("s_nop 1\n\tv_permlane32_swap_b32 %0, %1" : "+v"(a), "+v"(b)); return a + b; }
    else return v + __builtin_bit_cast(float, __builtin_amdgcn_ds_swizzle(__builtin_bit_cast(int, v), (K << 10) | 0x1f));
}
typedef float f32x2 __attribute__((ext_vector_type(2)));
struct EpiStore {
    static constexpr bool PERM = true, AFTER_DRAIN = false;
    bf16_t* O; bf16_t* O2; int ldc; float scale; int mode;
    __device__ __forceinline__ void operator()(f32x4 (&acc)[2][2][4][2], const Unit& u, int wr, int wc, int fr, int fq) const {
        bf16_t* base = O; int ld = ldc; int row0, col0;
        if (mode == 0) { row0 = u.pm * BM; col0 = u.pn * BM; }
        else if (mode == 1) { row0 = (u.pn >> 1) * 4096 + u.pm * BM; col0 = 512 + (u.pn & 1) * BM; }
        else { const int sec = u.pm >> 1, b = u.pn >> 4, s0 = (u.pn & 15) * BM; row0 = b * 512 + (u.pm & 1) * BM;
               if (sec == 0) { base = O; ld = 4096; col0 = s0; } else { base = O2; ld = 8192; col0 = s0 + (sec == 2 ? 4096 : 0); } }
        row0 += wr * 64 + fr; col0 += wc * 32 + 8 * fq;
        const float sc = scale;
#pragma unroll
        for (int ai = 0; ai < 2; ++ai)
#pragma unroll
            for (int m = 0; m < 4; ++m) { bf16_t* rowp = base + (size_t)(row0 + ai * HALF + m * 16) * ld + col0;
#pragma unroll
                for (int bj = 0; bj < 2; ++bj) { const f32x4 v0 = acc[ai][bj][m][0] * sc, v1 = acc[ai][bj][m][1] * sc;
                    u32x4 w; w.x = cvt_pk_bf16(v0[0], v0[1]); w.y = cvt_pk_bf16(v0[2], v0[3]); w.z = cvt_pk_bf16(v1[0], v1[1]); w.w = cvt_pk_bf16(v1[2], v1[3]);
                    *(u32x4*)(rowp + bj * HALF) = w; } }
    }
};
struct EpiRes {
    static constexpr bool PERM = false, AFTER_DRAIN = false;
    const float* base; float* out; bf16_t* xb; float* ss; float accscale;
    __device__ __forceinline__ void operator()(f32x4 (&acc)[2][2][4][2], const Unit& u, int wr, int wc, int fr, int fq) const {
        const int col0 = u.pn * BM + wc * 32 + 4 * fq;
#pragma unroll
        for (int ai = 0; ai < 2; ++ai)
#pragma unroll
            for (int m = 0; m < 4; ++m) { const int row = u.pm * BM + ai * HALF + wr * 64 + m * 16 + fr; const size_t off = (size_t)row * 1024 + col0; float q = 0.f;
#pragma unroll
                for (int bj = 0; bj < 2; ++bj)
#pragma unroll
                    for (int n = 0; n < 2; ++n) { const f32x4 bs = *(const f32x4*)(base + off + bj * HALF + n * 16); const f32x4 o = bs + acc[ai][bj][m][n] * accscale;
                        *(f32x4*)(out + off + bj * HALF + n * 16) = o; q += (o[0] * o[0] + o[1] * o[1]) + (o[2] * o[2] + o[3] * o[3]);
                        if (xb) { typedef unsigned u32x2v __attribute__((ext_vector_type(2))); u32x2v w; w.x = cvt_pk_bf16(o[0], o[1]); w.y = cvt_pk_bf16(o[2], o[3]); *(u32x2v*)(xb + off + bj * HALF + n * 16) = w; } }
                q = xsum<16>(q); q = xsum<32>(q);
                if (fq == 0) ss[(size_t)row * 16 + u.pn * 4 + wc] = q; }
    }
};
struct EpiConv {
    static constexpr bool PERM = true, AFTER_DRAIN = false;
    const float* ss; const float* wconv; const float* bconv; bf16_t* G; float* halo; PG8_LAS float* xch;
    __device__ __forceinline__ void operator()(f32x4 (&acc)[2][2][4][2], const Unit& u, int wr_, int wc_, int fr_, int fq_) const {
        int t_ = threadIdx.x; asm volatile("" : "+v"(t_));
        const int wid_ = __builtin_amdgcn_readfirstlane(t_ >> 6), wr = wid_ >> 2, wc = wid_ & 3, fr = t_ & 15, fq = (t_ >> 4) & 3; (void)wr_; (void)wc_; (void)fr_; (void)fq_;
        const int beta = 16 * wr + fr; const unsigned tok0 = (unsigned)(u.pm * BM + 8 * beta);
        float rs[8];
        { const char* sp = (const char*)ss + (size_t)((tok0 * 16u + 4u * (unsigned)fq) * 4u);
#pragma unroll
        for (int j = 0; j < 8; ++j) { const f32x4 a = *(const f32x4*)(sp + j * 64); float s = (a[0] + a[1]) + (a[2] + a[3]);
            s = xsum<16>(s); s = xsum<32>(s);
            rs[j] = __builtin_amdgcn_rsqf(s * (1.0f / 1024.0f) + 1e-6f); } }
#pragma unroll
        for (int ai = 0; ai < 2; ++ai)
#pragma unroll
            for (int m = 0; m < 4; ++m)
#pragma unroll
                for (int bj = 0; bj < 2; ++bj)
#pragma unroll
                    for (int n = 0; n < 2; ++n) acc[ai][bj][m][n] = acc[ai][bj][m][n] * rs[m + 4 * ai];
        if (fr == 0) { PG8_LAS f32x4* d = (PG8_LAS f32x4*)(xch + ((((wr * 4 + wc) * 2 + 0) * 4 + fq) * 16));
            d[0] = acc[0][0][0][0]; d[1] = acc[0][0][0][1]; d[2] = acc[0][1][0][0]; d[3] = acc[0][1][0][1]; }
        if (fr == 15) { PG8_LAS f32x4* d = (PG8_LAS f32x4*)(xch + ((((wr * 4 + wc) * 2 + 1) * 4 + fq) * 16));
            d[0] = acc[1][0][3][0]; d[1] = acc[1][0][3][1]; d[2] = acc[1][1][3][0]; d[3] = acc[1][1][3][1]; }
        if (beta == 0 || beta == 31) { const int hr = beta == 0 ? 0 : 2; char* hp = (char*)halo + (size_t)((((unsigned)u.pm * 4u + (unsigned)hr) * 5632u + (unsigned)(u.pn * BM + wc * 32 + 8 * fq)) * 4u);
#pragma unroll
            for (int t = 0; t < 2; ++t)
#pragma unroll
                for (int bj = 0; bj < 2; ++bj)
#pragma unroll
                    for (int n = 0; n < 2; ++n) *(f32x4*)(hp + (t * 5632 + bj * HALF + 4 * n) * 4) = beta == 0 ? acc[0][bj][t][n] : acc[1][bj][2 + t][n]; }
        asm volatile("s_waitcnt lgkmcnt(0)\n\ts_barrier" ::: "memory");
        const unsigned jg0 = (unsigned)(u.pn * 128 + wc * 32 + 8 * fq);
#pragma unroll
        for (int n = 0; n < 2; ++n)
#pragma unroll
            for (int bj = 0; bj < 2; ++bj) {
                const unsigned jc = (jg0 + 4u * n + bj * 2816u) * 4u;
                const f32x4 w0 = *(const f32x4*)((const char*)wconv + (size_t)jc), w1 = *(const f32x4*)((const char*)wconv + (size_t)(jc + 5632u * 4u)), w2 = *(const f32x4*)((const char*)wconv + (size_t)(jc + 2u * 5632u * 4u)), bb = *(const f32x4*)((const char*)bconv + (size_t)jc);
                f32x4 prv, nxt;
#pragma unroll
                for (int e = 0; e < 4; ++e) { float pa, na; const float sa = acc[1][bj][3][n][e], sb = acc[0][bj][0][n][e];
                    asm volatile("s_nop 1\n\tv_mov_b32_dpp %0, %2 row_shr:1 row_mask:0xf bank_mask:0xf bound_ctrl:1\n\tv_mov_b32_dpp %1, %3 row_shl:1 row_mask:0xf bank_mask:0xf bound_ctrl:1" : "=&v"(pa), "=&v"(na) : "v"(sa), "v"(sb));
                    prv[e] = pa; nxt[e] = na; }
                if (fr == 0) { if (wr == 1) prv = *(const PG8_LAS f32x4*)(xch + ((((0 * 4 + wc) * 2 + 1) * 4 + fq) * 16) + bj * 8 + n * 4); }
                if (fr == 15) { if (wr == 0) nxt = *(const PG8_LAS f32x4*)(xch + ((((1 * 4 + wc) * 2 + 0) * 4 + fq) * 16) + bj * 8 + n * 4); }
                f32x4 old = prv;
#pragma unroll
                for (int j = 0; j < 8; ++j) { const f32x4 cu = acc[j >> 2][bj][j & 3][n]; const f32x4 dn = j == 7 ? nxt : acc[(j + 1) >> 2][bj][(j + 1) & 3][n];
                    acc[j >> 2][bj][j & 3][n] = w0 * old + w1 * cu + w2 * dn + bb; old = cu; }
            }
        unsigned goff = (tok0 * 2816u + jg0) * 2u;
#pragma unroll
        for (int j = 0; j < 8; ++j) { unsigned w[4];
#pragma unroll
            for (int n = 0; n < 2; ++n) { const f32x4 g = acc[j >> 2][0][j & 3][n], v = acc[j >> 2][1][j & 3][n]; float r[4];
#pragma unroll
                for (int e = 0; e < 4; ++e) r[e] = g[e] * __builtin_amdgcn_rcpf(1.0f + __builtin_amdgcn_exp2f(-1.4426950408889634f * g[e])) * v[e];
                w[2 * n] = cvt_pk_bf16(r[0], r[1]); w[2 * n + 1] = cvt_pk_bf16(r[2], r[3]); }
            *(u32x4*)((char*)G + (size_t)goff) = (u32x4){w[0], w[1], w[2], w[3]}; goff += 5632u; }
    }
};
template <class Epi, class Sched, bool ALIGN_EPI = false, bool SP2 = false, bool APERM = false>
__device__ __forceinline__ void gemm_phase(PG8_LAS unsigned char* lds, const Gemm g, const Sched& S, const Epi& E) {
    int tid = threadIdx.x; asm volatile("" : "+v"(tid)); const int wid = __builtin_amdgcn_readfirstlane(tid >> 6), lane = tid & 63, wr = wid >> 2, wc = wid & 3, fr = lane & 15, fq = lane >> 4;
    const int K = g.K, nt = K / BK;
    unsigned voffA[2], voffB[2];
#pragma unroll
    for (int i = 0; i < 2; ++i) { int R, C; stage_rc(tid * 16 + i * 8192, R, C); const int Rb = Epi::PERM ? ((R & ~31) + perm32(R & 31)) : R;
        const int Ra = APERM ? (8 * (16 * ((R >> 6) & 1) + (R & 15)) + ((R >> 4) & 3)) : R; voffA[i] = (unsigned)(Ra * K + C) * 2u; voffB[i] = (unsigned)(Rb * K + C) * 2u; }
    const size_t voffA_d = (size_t)(APERM ? 128 : 64) * K * 2, voffB_d = (size_t)64 * K * 2;
    const size_t kstep = (size_t)(BK * 2);
    const size_t hstep = (size_t)HALF * K * 2;
    const size_t tstep = 2 * hstep; const size_t hstepA = APERM ? (size_t)4 * K * 2 : hstep;
    const unsigned ldsw = (unsigned)wid * 1024u;
    const int aoff = lds_byte(wr * 64 + fr, fq * 8), boff = lds_byte(wc * 32 + fr, fq * 8);
#define PG8_SA(b, h) (((b) * 2 + (h)) * HTB)
#define PG8_SB(b, h) ((4 + (b) * 2 + (h)) * HTB)
#define PG8_STAGE(bufoff, gbase, voff) do { _Pragma("unroll") for (int _i = 0; _i < 2; ++_i) \
        __builtin_amdgcn_global_load_lds((const unsigned*)((const char*)(gbase) + (size_t)_i * voff##_d + (voff)[0]), (PG8_LAS unsigned*)(lds + (bufoff) + ldsw + _i * 8192), 16, 0, 0); } while (0)
#define PG8_LDA(dst, b, h) do { _Pragma("unroll") for (int m = 0; m < 4; ++m) _Pragma("unroll") for (int k = 0; k < 2; ++k) dst[m][k] = *(const PG8_LAS bf16x8*)(lds + PG8_SA(b, h) + aoff + m * 2048 + k * 1024); } while (0)
#define PG8_LDB(dst, b, h) do { _Pragma("unroll") for (int n = 0; n < 2; ++n) _Pragma("unroll") for (int k = 0; k < 2; ++k) dst[n][k] = *(const PG8_LAS bf16x8*)(lds + PG8_SB(b, h) + boff + n * 2048 + k * 1024); } while (0)
#define PG8_MMA(ai, bj, At, Bt) do { __builtin_amdgcn_s_setprio(1); _Pragma("unroll") for (int m = 0; m < 4; ++m) _Pragma("unroll") for (int n = 0; n < 2; ++n) _Pragma("unroll") for (int k = 0; k < 2; ++k) \
        acc[ai][bj][m][n] = __builtin_amdgcn_mfma_f32_16x16x32_bf16(Bt[n][k], At[m][k], acc[ai][bj][m][n], 0, 0, 0); __builtin_amdgcn_s_setprio(0); } while (0)
#define PG8_WAIT_V(n) asm volatile("s_waitcnt vmcnt(" #n ")" ::: "memory")
#define PG8_WAIT_L(n) asm volatile("s_waitcnt lgkmcnt(" #n ")" ::: "memory")
#define PG8_BAR __builtin_amdgcn_s_barrier()
#define PG8_SCHED __builtin_amdgcn_sched_barrier(0)
    Unit cur, nxt; int ui = 0;
    if (!S.next(0, cur)) return;
    f32x4 acc[2][2][4][2];
#pragma unroll
    for (int a = 0; a < 2; ++a)
#pragma unroll
        for (int b = 0; b < 2; ++b)
#pragma unroll
            for (int m = 0; m < 4; ++m)
#pragma unroll
                for (int n = 0; n < 2; ++n) acc[a][b][m][n] = (f32x4){0.f, 0.f, 0.f, 0.f};
    bf16x8 At[4][2], B0[2][2], B1[2][2];
    const char* cA = (const char*)g.A + (size_t)cur.pm * tstep; const char* cB = (const char*)g.Bt + (size_t)cur.pn * tstep;
    S.a_ready(cur);
    if constexpr (SP2) {
        PG8_STAGE(PG8_SB(0, 0), cB, voffB); PG8_STAGE(PG8_SB(0, 1), cB + hstep, voffB); PG8_STAGE(PG8_SA(0, 0), cA, voffA); PG8_STAGE(PG8_SA(0, 1), cA + hstepA, voffA);
        if (wr == 1) PG8_BAR;
        PG8_WAIT_V(2); PG8_BAR;
        PG8_STAGE(PG8_SB(1, 0), cB + kstep, voffB); PG8_STAGE(PG8_SA(1, 0), cA + kstep, voffA); PG8_STAGE(PG8_SB(1, 1), cB + hstep + kstep, voffB);
        PG8_WAIT_V(6); PG8_BAR;
    } else {
        PG8_STAGE(PG8_SB(0, 0), cB, voffB); PG8_STAGE(PG8_SA(0, 0), cA, voffA); PG8_STAGE(PG8_SB(0, 1), cB + hstep, voffB); PG8_STAGE(PG8_SA(0, 1), cA + hstepA, voffA);
        if (wr == 1) PG8_BAR;
        PG8_WAIT_V(4); PG8_BAR;
        PG8_STAGE(PG8_SB(1, 0), cB + kstep, voffB); PG8_STAGE(PG8_SA(1, 0), cA + kstep, voffA); PG8_STAGE(PG8_SB(1, 1), cB + hstep + kstep, voffB);
        PG8_WAIT_V(6); PG8_BAR;
    }
    for (;;) {
        const bool has_next = S.next(ui + 1, nxt);
        const char* nA = has_next ? (const char*)g.A + (size_t)nxt.pm * tstep : cA; const char* nB = has_next ? (const char*)g.Bt + (size_t)nxt.pn * tstep : cB;
        for (int t = 0; t < nt; t += 2) {
            const bool last = (t == nt - 2);
            const char* a1 = cA + (size_t)(t + 1) * kstep;
            const char* a2 = last ? nA : cA + (size_t)(t + 2) * kstep; const char* b2 = last ? nB : cB + (size_t)(t + 2) * kstep;
            const char* a3 = a2 + kstep; const char* b3 = b2 + kstep;
            if (last && has_next) S.a_ready(nxt);
            if constexpr (SP2) {
            PG8_LDB(B0, 0, 0); PG8_LDB(B1, 0, 1); PG8_SCHED; PG8_LDA(At, 0, 0); PG8_STAGE(PG8_SA(1, 1), a1 + hstepA, voffA);
            PG8_WAIT_V(8); PG8_WAIT_L(0); PG8_BAR; PG8_MMA(0, 0, At, B0); PG8_MMA(0, 1, At, B1); PG8_BAR; PG8_SCHED;
            PG8_LDA(At, 0, 1); PG8_STAGE(PG8_SB(0, 0), b2, voffB); PG8_STAGE(PG8_SB(0, 1), b2 + hstep, voffB); PG8_STAGE(PG8_SA(0, 0), a2, voffA);
            PG8_WAIT_V(8); PG8_WAIT_L(0); PG8_BAR; PG8_MMA(1, 0, At, B0); PG8_MMA(1, 1, At, B1); PG8_BAR; PG8_SCHED;
            PG8_LDB(B0, 1, 0); PG8_LDB(B1, 1, 1); PG8_SCHED; PG8_LDA(At, 1, 0); PG8_STAGE(PG8_SA(0, 1), a2 + hstepA, voffA);
            PG8_WAIT_V(8); PG8_WAIT_L(0); PG8_BAR; PG8_MMA(0, 0, At, B0); PG8_MMA(0, 1, At, B1); PG8_BAR; PG8_SCHED;
            PG8_LDA(At, 1, 1); PG8_STAGE(PG8_SB(1, 0), b3, voffB); PG8_STAGE(PG8_SB(1, 1), b3 + hstep, voffB); PG8_STAGE(PG8_SA(1, 0), a3, voffA);
            PG8_WAIT_V(8); PG8_WAIT_L(0); PG8_BAR; PG8_MMA(1, 0, At, B0); PG8_MMA(1, 1, At, B1); PG8_BAR; PG8_SCHED;
            } else {
            PG8_LDB(B0, 0, 0); PG8_SCHED; PG8_LDA(At, 0, 0); PG8_STAGE(PG8_SA(1, 1), a1 + hstepA, voffA);
            PG8_WAIT_L(8); PG8_BAR; PG8_WAIT_L(0); PG8_MMA(0, 0, At, B0); PG8_BAR; PG8_SCHED;
            PG8_LDB(B1, 0, 1); PG8_STAGE(PG8_SB(0, 0), b2, voffB);
            PG8_BAR; PG8_WAIT_L(0); PG8_MMA(0, 1, At, B1); PG8_BAR;
            PG8_LDA(At, 0, 1); PG8_STAGE(PG8_SA(0, 0), a2, voffA);
            PG8_BAR; PG8_WAIT_L(0); PG8_MMA(1, 0, At, B0); PG8_BAR; PG8_SCHED;
            PG8_STAGE(PG8_SB(0, 1), b2 + hstep, voffB);
            PG8_WAIT_V(6); PG8_BAR; PG8_MMA(1, 1, At, B1); PG8_BAR;
            PG8_LDB(B0, 1, 0); PG8_SCHED; PG8_LDA(At, 1, 0); PG8_STAGE(PG8_SA(0, 1), a2 + hstepA, voffA);
            PG8_WAIT_L(8); PG8_BAR; PG8_WAIT_L(0); PG8_MMA(0, 0, At, B0); PG8_BAR; PG8_SCHED;
            PG8_LDB(B1, 1, 1); PG8_STAGE(PG8_SB(1, 0), b3, voffB);
            PG8_BAR; PG8_WAIT_L(0); PG8_MMA(0, 1, At, B1); PG8_BAR;
            PG8_LDA(At, 1, 1); PG8_STAGE(PG8_SA(1, 0), a3, voffA);
            PG8_BAR; PG8_WAIT_L(0); PG8_MMA(1, 0, At, B0); PG8_BAR; PG8_SCHED;
            PG8_STAGE(PG8_SB(1, 1), b3 + hstep, voffB);
            PG8_WAIT_V(6); PG8_BAR; PG8_MMA(1, 1, At, B1); PG8_BAR;
            }
        }
        if constexpr (ALIGN_EPI) { if (wr == 0) PG8_BAR; }
        if constexpr (!Epi::AFTER_DRAIN) { E(acc, cur, wr, wc, fr, fq); S.done(cur); }
        if (!has_next) break;
#pragma unroll
        for (int a = 0; a < 2; ++a)
#pragma unroll
            for (int b = 0; b < 2; ++b)
#pragma unroll
                for (int m = 0; m < 4; ++m)
#pragma unroll
                    for (int n = 0; n < 2; ++n) acc[a][b][m][n] = (f32x4){0.f, 0.f, 0.f, 0.f};
        cur = nxt; cA = nA; cB = nB; ++ui;
        if constexpr (ALIGN_EPI) { if (wr == 1) PG8_BAR; }
    }
    PG8_WAIT_V(0);
    if constexpr (!ALIGN_EPI) { if (wr == 0) PG8_BAR; }
    PG8_BAR;
    if constexpr (Epi::AFTER_DRAIN) { E.fused(acc, cur, wr, wc, fr, fq, lds, wid, lane); S.done(cur); }
#undef PG8_SA
#undef PG8_SB
#undef PG8_STAGE
#undef PG8_LDA
#undef PG8_LDB
#undef PG8_MMA
#undef PG8_WAIT_V
#undef PG8_WAIT_L
#undef PG8_BAR
#undef PG8_SCHED
}
}
namespace att {
#define LAS __attribute__((address_space(3)))
typedef unsigned short bf16_t;
typedef short bf16x8 __attribute__((ext_vector_type(8)));
typedef short s16x4 __attribute__((ext_vector_type(4)));
typedef float f32x16 __attribute__((ext_vector_type(16)));
typedef float f32x4 __attribute__((ext_vector_type(4)));
typedef unsigned u32x2 __attribute__((ext_vector_type(2)));
constexpr int SEQ = 4096, KVB = 64, NT = SEQ / KVB, KBUFB = 16384, VOFFB = 32768, QOFFB = 65536;
constexpr float LOG2E = 1.4426950408889634f;
__device__ __forceinline__ unsigned cvtpk(float lo, float hi) { unsigned r; asm volatile("v_cvt_pk_bf16_f32 %0, %1, %2" : "=v"(r) : "v"(lo), "v"(hi)); return r; }
__device__ __forceinline__ float swapmax(float v) { float a = v, b = v; asm volatile("s_nop 1\n\tv_permlane32_swap_b32 %0, %1" : "+v"(a), "+v"(b)); return fmaxf(a, b); }
__device__ __forceinline__ float swapsum(float v) { float a = v, b = v; asm volatile("s_nop 1\n\tv_permlane32_swap_b32 %0, %1" : "+v"(a), "+v"(b)); return a + b; }

__device__ __forceinline__ void attn_unit(LAS unsigned char* lds, const bf16_t* __restrict__ QK, const bf16_t* __restrict__ VT, bf16_t* __restrict__ MIX, const float* __restrict__ gsub, float lam, int b, int h, int qb) {
    int tid = threadIdx.x; asm volatile("" : "+v"(tid));
    const int lane = tid & 63, r32 = lane & 31, hi = lane >> 5; const int wid = __builtin_amdgcn_readfirstlane(tid >> 6);
    const float slope2 = __builtin_amdgcn_exp2f(-2.0f * (float)(h + 1)) * LOG2E;
    const int qpos = qb * 256 + wid * 32 + r32;
    { const char* Qg = (const char*)(QK + (size_t)(b * SEQ + qb * 256 + wid * 32) * 1024 + h * 128);
#pragma unroll
      for (int p = 0; p < 8; ++p) { const int row = 4 * p + (lane >> 4); const int c = (lane & 15) ^ (row & 15);
          __builtin_amdgcn_global_load_lds((const unsigned*)(Qg + (size_t)(row * 2048 + c * 16)), (LAS unsigned*)(lds + QOFFB + wid * 8192 + p * 1024), 16, 0, 0); } }
    const char* Kg = (const char*)(QK + (size_t)b * SEQ * 1024 + 512 + h * 128);
    const char* Vg = (const char*)(VT + (size_t)(b * 512 + h * 128) * 4096);
    unsigned koff[2], voff[2];
#pragma unroll
    for (int i = 0; i < 2; ++i) { const int p = wid + 8 * i; const int row = 4 * p + (lane >> 4); const int c = (lane & 15) ^ (row & 15); koff[i] = (unsigned)(row * 2048 + c * 16);
        const int dv = 8 * p + (lane >> 3); const int j = (lane & 7) ^ ((dv >> 1) & 7); voff[i] = (unsigned)(dv * 8192 + j * 16); }
#define ATT_DMA(t, buf) do { _Pragma("unroll") for (int i_ = 0; i_ < 2; ++i_) { \
        __builtin_amdgcn_global_load_lds((const unsigned*)(Kg + (size_t)(t) * (KVB * 2048) + koff[i_]), (LAS unsigned*)(lds + (buf) * KBUFB + (wid + 8 * i_) * 1024), 16, 0, 0); \
        __builtin_amdgcn_global_load_lds((const unsigned*)(Vg + (size_t)(t) * (KVB * 2) + voff[i_]), (LAS unsigned*)(lds + VOFFB + (buf) * KBUFB + (wid + 8 * i_) * 1024), 16, 0, 0); } } while (0)
    f32x16 O[2][4];
#pragma unroll
    for (int c = 0; c < 2; ++c)
#pragma unroll
        for (int k = 0; k < 4; ++k) O[c][k] = f32x16{};
    float mrun[2] = {-1e30f, -1e30f}, lrun[2] = {0.f, 0.f};
    const LAS unsigned char* Qb = lds + QOFFB + wid * 8192;
    ATT_DMA(0, 0);
    for (int t = 0; t < NT; ++t) {
        asm volatile("s_waitcnt vmcnt(0)\n\ts_barrier" ::: "memory");
        if (t + 1 < NT) ATT_DMA(t + 1, (t + 1) & 1);
        int ln_ = lane; asm volatile("" : "+v"(ln_));
        const int r32 = ln_ & 31, hi = ln_ >> 5;
        const int ksw = r32 & 15; const int kbase = r32 * 256; const int vsw = (r32 >> 1) & 7; const int vbase = r32 * 128 + 8 * hi;
        const LAS unsigned char* Kb = lds + (t & 1) * KBUFB; const LAS unsigned char* Vb = lds + VOFFB + (t & 1) * KBUFB;
        const float dq = (float)(qpos - t * KVB - 4 * hi);
#pragma unroll
        for (int c = 0; c < 2; ++c)
#pragma unroll
        for (int hf = 0; hf < 2; ++hf) {
            bf16x8 pk[2];
            {
            f32x16 p0 = f32x16{};
#pragma unroll
            for (int d0 = 0; d0 < 4; ++d0) {
                const int ch = ((c * 8 + d0 * 2 + hi) ^ ksw) * 16;
                const bf16x8 a0 = *(const LAS bf16x8*)(Kb + kbase + ch + hf * 8192);
                const bf16x8 qv = *(const LAS bf16x8*)(Qb + kbase + ch);
                p0 = __builtin_amdgcn_mfma_f32_32x32x16_bf16(a0, qv, p0, 0, 0, 0);
                if (d0 & 1) asm volatile("" ::: "memory");
            }
            float tm = -1e30f;
#pragma unroll
            for (int r = 0; r < 16; ++r) { const float cr = (float)((r & 3) + 8 * (r >> 2) + 32 * hf);
                p0[r] = p0[r] - slope2 * fabsf(dq - cr); tm = fmaxf(tm, p0[r]); }
            tm = swapmax(tm);
            const float mnew = fmaxf(mrun[c], tm);
            if (__any(mnew > mrun[c])) { const float f = __builtin_amdgcn_exp2f(mrun[c] - mnew); lrun[c] *= f;
#pragma unroll
                for (int k = 0; k < 4; ++k)
#pragma unroll
                    for (int r = 0; r < 16; ++r) O[c][k][r] *= f;
                mrun[c] = mnew; }
            float s = 0.f;
#pragma unroll
            for (int r = 0; r < 16; ++r) { p0[r] = __builtin_amdgcn_exp2f(p0[r] - mnew); s += p0[r]; }
            lrun[c] += s;
#pragma unroll
            for (int k2 = 0; k2 < 2; ++k2) {
                typedef unsigned u32x4v __attribute__((ext_vector_type(4)));
                u32x4v w0;
                w0.x = cvtpk(p0[8 * k2 + 0], p0[8 * k2 + 1]); w0.y = cvtpk(p0[8 * k2 + 2], p0[8 * k2 + 3]); w0.z = cvtpk(p0[8 * k2 + 4], p0[8 * k2 + 5]); w0.w = cvtpk(p0[8 * k2 + 6], p0[8 * k2 + 7]);
                pk[k2] = __builtin_bit_cast(bf16x8, w0); }
            }
#pragma unroll
            for (int blk = 0; blk < 4; ++blk) {
#pragma unroll
                for (int k2 = 0; k2 < 2; ++k2) { const int ks = 2 * hf + k2;
                    const s16x4 v0 = *(const LAS s16x4*)(Vb + blk * 4096 + vbase + (((2 * ks) ^ vsw) * 16));
                    const s16x4 v1 = *(const LAS s16x4*)(Vb + blk * 4096 + vbase + (((2 * ks + 1) ^ vsw) * 16));
                    const bf16x8 vf = (bf16x8){v0[0], v0[1], v0[2], v0[3], v1[0], v1[1], v1[2], v1[3]};
                    O[c][blk] = __builtin_amdgcn_mfma_f32_32x32x16_bf16(vf, pk[k2], O[c][blk], 0, 0, 0);
                }
                asm volatile("" ::: "memory");
            }
        }
    }
#undef ATT_DMA
    const float i1 = 1.0f / swapsum(lrun[0]), i2 = lam / swapsum(lrun[1]);
    float ssq = 0.f;
#pragma unroll
    for (int k = 0; k < 4; ++k)
#pragma unroll
        for (int r = 0; r < 16; ++r) { const float o = O[0][k][r] * i1 - O[1][k][r] * i2; O[0][k][r] = o; ssq += o * o; }
    ssq = swapsum(ssq);
    const float rn = __builtin_amdgcn_rsqf(ssq * (1.0f / 128.0f) + 1e-5f) * 0.8f * ABL_ATT;
    bf16_t* orow = MIX + (size_t)(b * SEQ + qpos) * 1024 + h * 128;
#pragma unroll
    for (int k = 0; k < 4; ++k)
#pragma unroll
        for (int g = 0; g < 4; ++g) { const int dv = 32 * k + 8 * g + 4 * hi; const f32x4 gs = *(const f32x4*)(gsub + dv);
            u32x2 w; w.x = cvtpk(O[0][k][4 * g] * rn * gs[0], O[0][k][4 * g + 1] * rn * gs[1]); w.y = cvtpk(O[0][k][4 * g + 2] * rn * gs[2], O[0][k][4 * g + 3] * rn * gs[3]);
            *(u32x2*)(orow + dv) = w; }
}
#undef LAS
}
#define GAS __attribute__((address_space(1)))
#define LAS __attribute__((address_space(3)))
typedef unsigned short bf16;
typedef unsigned v4u __attribute__((ext_vector_type(4)));
typedef float f32x4 __attribute__((ext_vector_type(4)));
constexpr int NWAVES = 8;
constexpr int BATCH = 8, SEQ = 4096, DM = 1024, MTOK = BATCH * SEQ, DFF = 2816, NUP = 2 * DFF;
constexpr size_t MiB = 1u << 20;
constexpr size_t WS_WQK = 2 * MiB, WS_WVAB = 4 * MiB, WS_WOUT = 8 * MiB, WS_WUP = 10 * MiB, WS_WDOWN = 22 * MiB, WS_SS1 = 28 * MiB, WS_SS2 = 30 * MiB, WS_HALO = 32 * MiB;
constexpr size_t WS_XN = 48 * MiB, WS_QK = 112 * MiB, WS_VT = 176 * MiB, WS_T = 208 * MiB, WS_DFT = 272 * MiB, WS_MIX = 336 * MiB, WS_XB2 = 400 * MiB, WS_G = 48 * MiB, WS_END = 464 * MiB;
constexpr int RING_BYTES = 131072, XCH_OFF = RING_BYTES, TAB_OFF = RING_BYTES + 4096, LDS_BYTES = 147456;

__device__ __forceinline__ unsigned f2bf(float f) { unsigned u = __builtin_bit_cast(unsigned, f); return (u + 0x7fffu + ((u >> 16) & 1u)) >> 16; }
__device__ __forceinline__ unsigned pk2(float lo, float hi) { return f2bf(lo) | (f2bf(hi) << 16); }
__device__ __forceinline__ float wave_sum(float v) { v = pg8::xsum<1>(v); v = pg8::xsum<2>(v); v = pg8::xsum<4>(v); v = pg8::xsum<8>(v); v = pg8::xsum<16>(v); v = pg8::xsum<32>(v); return v; }
__device__ __forceinline__ void tr_item(const float* W, int ldw, int k0, int sc0, const float* ks, float nscale, bf16* dst, int ldd, int n0, LAS float* scr, int lane) {
#pragma unroll 8
    for (int i = 0; i < 32; ++i) { const int kk = 2 * i + (lane >> 5); float v = W[(size_t)(k0 + kk) * ldw + sc0 + (lane & 31)] * nscale; if (ks) v *= ks[k0 + kk]; scr[kk * 33 + (lane & 31)] = v; }
    asm volatile("s_waitcnt lgkmcnt(0)" ::: "memory");
    const int c = lane & 7;
#pragma unroll
    for (int j = 0; j < 4; ++j) { const int n = (lane >> 3) + 8 * j; const LAS float* s = scr + (8 * c) * 33 + n;
        v4u o; o.x = pk2(s[0 * 33], s[1 * 33]); o.y = pk2(s[2 * 33], s[3 * 33]); o.z = pk2(s[4 * 33], s[5 * 33]); o.w = pk2(s[6 * 33], s[7 * 33]);
        *(v4u*)(dst + (size_t)(n0 + n) * ldd + k0 + 8 * c) = o; }
    asm volatile("s_waitcnt lgkmcnt(0)" ::: "memory");
}


#ifndef PROBE
#define PROBE 0
#endif
#if PROBE
__device__ __forceinline__ float bf2f(bf16 v) { return __builtin_bit_cast(float, (unsigned)v << 16); }
__device__ __forceinline__ unsigned hash32(unsigned x) { x ^= x >> 16; x *= 0x7feb352dU; x ^= x >> 15; x *= 0x846ca68bU; x ^= x >> 16; return x; }
__device__ __forceinline__ float wdot_bf(const bf16* a, const bf16* b, int K, int lane) { float s = 0.f; for (int k = lane; k < K; k += 64) s += bf2f(a[k]) * bf2f(b[k]); return wave_sum(s); }
__device__ __forceinline__ float wave_max(float v) {
    v = fmaxf(v, __builtin_bit_cast(float, __builtin_amdgcn_ds_swizzle(__builtin_bit_cast(int, v), (1 << 10) | 0x1f)));
    v = fmaxf(v, __builtin_bit_cast(float, __builtin_amdgcn_ds_swizzle(__builtin_bit_cast(int, v), (2 << 10) | 0x1f)));
    v = fmaxf(v, __builtin_bit_cast(float, __builtin_amdgcn_ds_swizzle(__builtin_bit_cast(int, v), (4 << 10) | 0x1f)));
    v = fmaxf(v, __builtin_bit_cast(float, __builtin_amdgcn_ds_swizzle(__builtin_bit_cast(int, v), (8 << 10) | 0x1f)));
    v = fmaxf(v, __builtin_bit_cast(float, __builtin_amdgcn_ds_swizzle(__builtin_bit_cast(int, v), (16 << 10) | 0x1f)));
    float a = v, b = v; asm volatile("s_nop 1\n\tv_permlane32_swap_b32 %0, %1" : "+v"(a), "+v"(b)); return fmaxf(a, b);
}
__device__ __forceinline__ void acc_err(float* E, int i, float d2, float w2, int lane) { if (lane == 0) { atomicAdd(E + 2 * i, d2); atomicAdd(E + 2 * i + 1, w2); } }
#endif
struct Args { const float* in[16]; float* out; unsigned char* ws; };

__global__ void __launch_bounds__(NWAVES * 64, 2) fwd_mega(Args args) {
    extern __shared__ __attribute__((aligned(16))) unsigned char lds_raw[];
    cg::grid_group grid = cg::this_grid();
    LAS unsigned char* lds = (LAS unsigned char*)lds_raw;
#define FRESH() int tid = threadIdx.x; asm volatile("" : "+v"(tid)); const int lane = tid & 63, wave = __builtin_amdgcn_readfirstlane(tid >> 6); const int gw = bid * NWAVES + wave, NGW = G * NWAVES; const int gt = bid * (NWAVES * 64) + tid, NGT = G * NWAVES * 64; (void)lane; (void)gw; (void)NGW; (void)gt; (void)NGT
    const int G = gridDim.x, bid = blockIdx.x;
    unsigned char* ws = args.ws;
    const float* x = args.in[0]; const float* g_mix = args.in[1]; const float* w_in = args.in[2];
    const float* g_subln = args.in[7]; const float* w_ft = args.in[8]; const float* w_out = args.in[9]; const float* g_ffn = args.in[10];
    const float* w_up = args.in[11]; const float* w_conv = args.in[12]; const float* b_conv = args.in[13]; const float* w_down = args.in[14]; const float* g_final = args.in[15];
    float* out = args.out;
    bf16* WQK = (bf16*)(ws + WS_WQK); bf16* WVAB = (bf16*)(ws + WS_WVAB); bf16* WOUT = (bf16*)(ws + WS_WOUT); bf16* WUP = (bf16*)(ws + WS_WUP); bf16* WDOWN = (bf16*)(ws + WS_WDOWN);
    float* SS1 = (float*)(ws + WS_SS1); float* SS2 = (float*)(ws + WS_SS2); float* HALO = (float*)(ws + WS_HALO);
    bf16* XN = (bf16*)(ws + WS_XN); bf16* QKB = (bf16*)(ws + WS_QK); bf16* VT = (bf16*)(ws + WS_VT); bf16* TB = (bf16*)(ws + WS_T); bf16* DFT = (bf16*)(ws + WS_DFT);
    bf16* MIX = (bf16*)(ws + WS_MIX); bf16* XB2 = (bf16*)(ws + WS_XB2); bf16* GB = (bf16*)(ws + WS_G);

    {
        FRESH();
#if PROBE
        if (bid == 0 && tid < 128) ((float*)(ws + 4096))[tid] = 0.f;
#endif
        LAS float* tab = (LAS float*)(lds + TAB_OFF);
        if (tid < 128) { tab[tid] = __builtin_amdgcn_cosf((float)tid * (1.0f / 128.0f)); tab[128 + tid] = __builtin_amdgcn_sinf((float)tid * (1.0f / 128.0f)); }
        __syncthreads();
        LAS float* scr = (LAS float*)(lds + wave * 16384);
        constexpr int I_QK = 32 * 16, I_V = 16 * 16, I_UP = 176 * 16, I_DN = 32 * 44, I_O = 32 * 8;
        constexpr int NITEMS = I_QK + I_V + I_UP + I_DN + I_O;
        for (int it = gw; it < NITEMS; it += NGW) {
            int r = it;
            if (r < I_QK) { const int nb = r % 32, kb = r / 32; tr_item(w_in, 2048, 64 * kb, 32 * nb, g_mix, nb < 16 ? 0.125f * 1.4426950408889634f : 1.0f, WQK, 1024, 32 * nb, scr, lane); continue; } r -= I_QK;
            if (r < I_V) { const int nb = r % 16, kb = r / 16; tr_item(w_in, 2048, 64 * kb, 1024 + 32 * nb, g_mix, 1.0f, WVAB, 1024, 32 * nb, scr, lane); continue; } r -= I_V;
            if (r < I_UP) { const int nb = r % 176, kb = r / 176; const int pn = nb >> 3, lb = nb & 7; const int sc = lb < 4 ? 128 * pn + 32 * lb : DFF + 128 * pn + 32 * (lb - 4);
                tr_item(w_up, NUP, 64 * kb, sc, g_ffn, 1.0f, WUP, 1024, 32 * nb, scr, lane); continue; } r -= I_UP;
            if (r < I_DN) { const int nb = r % 32, kb = r / 32; tr_item(w_down, 1024, 64 * kb, 32 * nb, nullptr, 1.0f, WDOWN, DFF, 32 * nb, scr, lane); continue; } r -= I_DN;
            { const int nb = r % 32, kb = r / 32; tr_item(w_out, 1024, 64 * kb, 32 * nb, nullptr, 1.0f, WOUT, 1024, 32 * nb, scr, lane); }
        }
        for (int e = gt; e < 1024 * 4 * 128; e += NGT) { const int c2 = e & 127, gi = (e >> 7) & 3, k = e >> 9; const float* wr_ = w_in + (size_t)k * 2048 + 1536 + gi * 128;
            float ac = 0.f, as = 0.f;
#pragma unroll 8
            for (int c = 0; c < 128; ++c) { const float w = wr_[c]; const int ix = (c * c2) & 127; ac += w * tab[ix]; as += w * tab[128 + ix]; }
            const float sc = g_mix[k] * 0.08838834764831845f;
            WVAB[(size_t)(512 + gi * 128 + c2) * 1024 + k] = (bf16)f2bf(ac * sc); WVAB[(size_t)(1024 + gi * 128 + c2) * 1024 + k] = (bf16)f2bf(as * sc); }
        for (int e = gt; e < 512 * 1024; e += NGT) { const int n = e & 1023, kc = e >> 10; const int gi = kc >> 7; const float* wf = w_ft + (size_t)kc * 128; const float* wo = w_out + (size_t)(512 + gi * 128) * 1024 + n;
            float a = 0.f;
#pragma unroll 8
            for (int d = 0; d < 128; ++d) a += wf[d] * wo[(size_t)d * 1024];
            WOUT[(size_t)n * 1024 + 512 + kc] = (bf16)f2bf(a); }
        for (int e = gt; e < 4096 * 1024; e += NGT) { const int sp = e >> 10, k8 = (e & 1023) * 8; const bool isS = k8 >= 4096; const int kk = k8 & 4095; unsigned w[4];
#pragma unroll
            for (int j = 0; j < 4; ++j) { float v[2];
#pragma unroll
                for (int q = 0; q < 2; ++q) { const float ph = (float)((sp * (kk + 2 * j + q)) & 4095) * (1.0f / 4096.0f); v[q] = isS ? -__builtin_amdgcn_sinf(ph) : __builtin_amdgcn_cosf(ph); }
                w[j] = pk2(v[0], v[1]); }
            *(v4u*)(DFT + (size_t)sp * 8192 + k8) = (v4u){w[0], w[1], w[2], w[3]}; }
        for (int m = gw; m < MTOK; m += NGW) { const f32x4* xr = (const f32x4*)(x + (size_t)m * DM) + lane; f32x4 v[4]; float s = 0.f;
#pragma unroll
            for (int j = 0; j < 4; ++j) { v[j] = xr[64 * j]; s += (v[j].x * v[j].x + v[j].y * v[j].y) + (v[j].z * v[j].z + v[j].w * v[j].w); }
            const float rstd = __builtin_amdgcn_rsqf(wave_sum(s) * (1.0f / DM) + 1e-6f);
            unsigned long long* o8 = (unsigned long long*)(XN + (size_t)m * DM) + lane;
#pragma unroll
            for (int j = 0; j < 4; ++j) o8[64 * j] = (unsigned long long)pk2(v[j].x * rstd, v[j].y * rstd) | ((unsigned long long)pk2(v[j].z * rstd, v[j].w * rstd) << 32); }
    }
    asm volatile("s_waitcnt vmcnt(0) lgkmcnt(0)" ::: "memory"); grid.sync();
    {
        { pg8::Gemm g{XN, WQK, MTOK, 1024, 1024}; pg8::StaticOrder S; S.init(MTOK, 1024, G, bid); pg8::EpiStore E{QKB, nullptr, 1024, 1.0f, 0};
          pg8::gemm_phase<pg8::EpiStore, pg8::StaticOrder, true, true, false>(lds, g, S, E); }
        { pg8::Gemm g{WVAB, XN, 1536, MTOK, 1024}; pg8::StaticOrder S; S.init(1536, MTOK, G, bid); pg8::EpiStore E{VT, TB, 0, 1.0f, 2};
          pg8::gemm_phase<pg8::EpiStore, pg8::StaticOrder, true, true, false>(lds, g, S, E); }
    }
    asm volatile("s_waitcnt vmcnt(0) lgkmcnt(0)" ::: "memory"); grid.sync();
    {
        FRESH();
        const float* lq1 = args.in[3]; const float* lk1 = args.in[4]; const float* lq2 = args.in[5]; const float* lk2 = args.in[6];
        const float d1 = wave_sum(lq1[lane] * lk1[lane]), d2 = wave_sum(lq2[lane] * lk2[lane]);
        const float lam = __expf(d1) - __expf(d2) + 0.2f;
        for (int uix = bid; uix < 512; uix += G) { const int bh = uix >> 4, qb = uix & 15; att::attn_unit(lds, QKB, VT, MIX, g_subln, lam, bh >> 2, bh & 3, qb); }
        asm volatile("s_waitcnt vmcnt(0) lgkmcnt(0)\n\ts_barrier" ::: "memory");
        { pg8::Gemm g{DFT, TB, 4096, 4096, 8192}; pg8::StaticOrder S; S.init(4096, 4096, G, bid); pg8::EpiStore E{MIX, nullptr, 1024, ABL_FT / 64.0f, 1};
          pg8::gemm_phase<pg8::EpiStore, pg8::StaticOrder, true, true, false>(lds, g, S, E); }
    }
    asm volatile("s_waitcnt vmcnt(0) lgkmcnt(0)" ::: "memory"); grid.sync();

#if PROBE
    {
        FRESH(); float* E = (float*)(ws + 4096);
        for (int s = 0; s < 2; ++s) { const unsigned id = hash32((unsigned)(gw * 2 + s) + 12345u); const int tok = id & 32767, col = (id >> 15) & 1023;
            const float want = wdot_bf(XN + (size_t)tok * 1024, WQK + (size_t)col * 1024, 1024, lane), got = bf2f(QKB[(size_t)tok * 1024 + col]); acc_err(E, 0, (got - want) * (got - want), want * want, lane);  acc_err(E, 6, got * want, want * want, lane);
            float wh; { float s_ = 0.f; for (int k = lane; k < 1024; k += 64) if (((k >> 6) & 1) == 0) s_ += bf2f(XN[(size_t)tok * 1024 + k]) * bf2f(WQK[(size_t)col * 1024 + k]); wh = wave_sum(s_); } acc_err(E, 7, (got - wh) * (got - wh), wh * wh, lane);
            const float wh2 = want - wh; acc_err(E, 8, (got - wh2) * (got - wh2), wh2 * wh2, lane);
            { const float bad = fabsf(got - want) > 0.1f * fabsf(want) + 0.02f ? 1.f : 0.f; const int hb[6] = {(tok >> 6) & 1, (tok >> 7) & 1, (col >> 7) & 1, (tok >> 4) & 1, (col >> 5) & 1, (tok >> 8) & 1};
              for (int h = 0; h < 6; ++h) acc_err(E, 10 + 2 * h + (hb[h] ? 0 : 1), bad, 1.f, lane); } }
        for (int s = 0; s < 2; ++s) { const unsigned id = hash32((unsigned)(gw * 2 + s) + 4711u); const int tok = id & 32767, col = (id >> 15) & 1023;
            const int k = lane * 16 + (id >> 25) % 16; const float wsrc = w_in[(size_t)k * 2048 + col] * g_mix[k] * (col < 512 ? 0.125f * 1.4426950408889634f : 1.0f), wgot = bf2f(WQK[(size_t)col * 1024 + k]);
            float ssq = 0.f; for (int kk = lane; kk < 1024; kk += 64) { const float xv = x[(size_t)tok * 1024 + kk]; ssq += xv * xv; } const float rstd = rsqrtf(wave_sum(ssq) * (1.0f / 1024.0f) + 1e-6f);
            const float xsrc = x[(size_t)tok * 1024 + k] * rstd, xgot = bf2f(XN[(size_t)tok * 1024 + k]);
            acc_err(E, 9, wave_sum((wgot - wsrc) * (wgot - wsrc)), wave_sum(wsrc * wsrc), lane); acc_err(E, 22, wave_sum((xgot - xsrc) * (xgot - xsrc)), wave_sum(xsrc * xsrc), lane); }
        for (int s = 0; s < 2; ++s) { const unsigned id = hash32((unsigned)(gw * 2 + s) + 777u); const int tok = id & 32767, n = (id >> 15) % 1536; const int b = tok >> 12, sq = tok & 4095;
            const float want = wdot_bf(WVAB + (size_t)n * 1024, XN + (size_t)tok * 1024, 1024, lane);
            const float got = n < 512 ? bf2f(VT[(size_t)(b * 512 + n) * 4096 + sq]) : n < 1024 ? bf2f(TB[(size_t)(b * 512 + n - 512) * 8192 + sq]) : bf2f(TB[(size_t)(b * 512 + n - 1024) * 8192 + 4096 + sq]);
            acc_err(E, 1, (got - want) * (got - want), want * want, lane); }
        { const unsigned id = hash32((unsigned)gw + 999u); const int b = id & 7, sp = (id >> 3) & 4095, c2 = (id >> 15) & 511;
            const float want = wdot_bf(DFT + (size_t)sp * 8192, TB + (size_t)(b * 512 + c2) * 8192, 8192, lane) * (1.0f / 64.0f), got = bf2f(MIX[(size_t)(b * 4096 + sp) * 1024 + 512 + c2]);
            acc_err(E, 3, (got - want) * (got - want), want * want, lane); }
        {
            const unsigned id = hash32((unsigned)gw + 4242u); const int b = id & 7, h = (id >> 3) & 3, q = (id >> 5) & 4095;
            const float* lq1 = args.in[3]; const float* lk1 = args.in[4]; const float* lq2 = args.in[5]; const float* lk2 = args.in[6];
            const float lam = __expf(wave_sum(lq1[lane] * lk1[lane])) - __expf(wave_sum(lq2[lane] * lk2[lane])) + 0.2f;
            const float slope2 = exp2f(-2.0f * (float)(h + 1)) * 1.4426950408889634f;
            const bf16* Qp = QKB + (size_t)(b * 4096 + q) * 1024 + h * 128; LAS float* av = (LAS float*)(lds + wave * 16384);
            float m0 = -1e30f, m1 = -1e30f, l0 = 0.f, l1 = 0.f;
            for (int kv = lane; kv < 4096; kv += 64) { const bf16* Kp = QKB + (size_t)(b * 4096 + kv) * 1024 + 512 + h * 128; float s0 = 0.f, s1 = 0.f;
                for (int d = 0; d < 64; ++d) { s0 += bf2f(Qp[d]) * bf2f(Kp[d]); s1 += bf2f(Qp[64 + d]) * bf2f(Kp[64 + d]); }
                const float bias = slope2 * fabsf((float)(q - kv)); s0 -= bias; s1 -= bias;
                { const float mn = fmaxf(m0, s0); l0 = l0 * exp2f(m0 - mn) + exp2f(s0 - mn); m0 = mn; } { const float mn = fmaxf(m1, s1); l1 = l1 * exp2f(m1 - mn) + exp2f(s1 - mn); m1 = mn; } }
            const float M0 = wave_max(m0), M1 = wave_max(m1); const float L0 = wave_sum(l0 * exp2f(m0 - M0)), L1 = wave_sum(l1 * exp2f(m1 - M1));
            for (int kv = lane; kv < 4096; kv += 64) { const bf16* Kp = QKB + (size_t)(b * 4096 + kv) * 1024 + 512 + h * 128; float s0 = 0.f, s1 = 0.f;
                for (int d = 0; d < 64; ++d) { s0 += bf2f(Qp[d]) * bf2f(Kp[d]); s1 += bf2f(Qp[64 + d]) * bf2f(Kp[64 + d]); }
                const float bias = slope2 * fabsf((float)(q - kv)); s0 -= bias; s1 -= bias;
                av[kv] = exp2f(s0 - M0) / L0 - lam * exp2f(s1 - M1) / L1; }
            asm volatile("s_waitcnt lgkmcnt(0)" ::: "memory");
            float o[2];
            for (int i = 0; i < 2; ++i) { const bf16* Vp = VT + (size_t)(b * 512 + h * 128 + lane + 64 * i) * 4096; float a = 0.f; for (int kv = 0; kv < 4096; ++kv) a += av[kv] * bf2f(Vp[kv]); o[i] = a; }
            const float rn = rsqrtf(wave_sum(o[0] * o[0] + o[1] * o[1]) * (1.0f / 128.0f) + 1e-5f) * 0.8f; float d2 = 0.f, w2 = 0.f;
            for (int i = 0; i < 2; ++i) { const float want = o[i] * rn * g_subln[lane + 64 * i], got = bf2f(MIX[(size_t)(b * 4096 + q) * 1024 + h * 128 + lane + 64 * i]); d2 += (got - want) * (got - want); w2 += want * want; }
            acc_err(E, 2, wave_sum(d2), wave_sum(w2), lane);
            asm volatile("s_waitcnt lgkmcnt(0)\n\ts_barrier" ::: "memory");
        }
    }
#endif
    { pg8::Gemm g{MIX, WOUT, MTOK, 1024, 1024}; pg8::StaticOrder S; S.init(MTOK, 1024, G, bid); pg8::EpiRes E{x, out, XB2, SS1, 1.0f};
      pg8::gemm_phase<pg8::EpiRes, pg8::StaticOrder, true, true, false>(lds, g, S, E); }
    asm volatile("s_waitcnt vmcnt(0) lgkmcnt(0)" ::: "memory"); grid.sync();

#if PROBE
    {
        FRESH(); float* E = (float*)(ws + 4096);
        for (int s = 0; s < 2; ++s) { const unsigned id = hash32((unsigned)(gw * 2 + s) + 31337u); const int tok = id & 32767, n = (id >> 15) & 1023;
            const float want = x[(size_t)tok * 1024 + n] + wdot_bf(MIX + (size_t)tok * 1024, WOUT + (size_t)n * 1024, 1024, lane), got = out[(size_t)tok * 1024 + n]; acc_err(E, 4, (got - want) * (got - want), want * want, lane); }
    }
#endif
    { pg8::Gemm g{XB2, WUP, MTOK, NUP, 1024}; pg8::StaticOrder S; S.init(MTOK, NUP, G, bid); pg8::EpiConv E{SS1, w_conv, b_conv, GB, HALO, (LAS float*)(lds + XCH_OFF)};
      pg8::gemm_phase<pg8::EpiConv, pg8::StaticOrder, true, true, true>(lds, g, S, E); }
    asm volatile("s_waitcnt vmcnt(0) lgkmcnt(0)" ::: "memory"); grid.sync();
    { FRESH();
    for (int e = gt; e < 128 * 2 * (DFF / 4); e += NGT) { const int j4 = (e % (DFF / 4)) * 4, pw = e / (DFF / 4), pm = pw >> 1, which = pw & 1; const int pn = j4 >> 7, lc = j4 & 127;
        const float* h0 = HALO + (size_t)pm * 4 * NUP + pn * 256 + lc; f32x4 cv[2];
#pragma unroll
        for (int bj = 0; bj < 2; ++bj) { const float* hb = h0 + bj * 128; f32x4 up, cu, dn; const f32x4 z = (f32x4){0.f, 0.f, 0.f, 0.f};
            if (which == 0) { up = (pm & 15) ? *(const f32x4*)(hb - (size_t)4 * NUP + (size_t)3 * NUP) : z; cu = *(const f32x4*)(hb); dn = *(const f32x4*)(hb + NUP); }
            else { up = *(const f32x4*)(hb + (size_t)2 * NUP); cu = *(const f32x4*)(hb + (size_t)3 * NUP); dn = ((pm & 15) != 15) ? *(const f32x4*)(hb + (size_t)4 * NUP) : z; }
            const int jc = j4 + bj * DFF; cv[bj] = *(const f32x4*)(w_conv + jc) * up + *(const f32x4*)(w_conv + NUP + jc) * cu + *(const f32x4*)(w_conv + 2 * NUP + jc) * dn + *(const f32x4*)(b_conv + jc); }
        float r[4];
#pragma unroll
        for (int q = 0; q < 4; ++q) { const float gg = cv[0][q]; r[q] = gg * __builtin_amdgcn_rcpf(1.0f + __builtin_amdgcn_exp2f(-1.4426950408889634f * gg)) * cv[1][q]; }
        *(unsigned long long*)(GB + (size_t)(pm * 256 + (which ? 255 : 0)) * DFF + j4) = (unsigned long long)pk2(r[0], r[1]) | ((unsigned long long)pk2(r[2], r[3]) << 32); } }
    asm volatile("s_waitcnt vmcnt(0) lgkmcnt(0)" ::: "memory"); grid.sync();

#if PROBE
    {
        FRESH(); float* E = (float*)(ws + 4096);
        for (int s = 0; s < 2; ++s) { const unsigned id = hash32((unsigned)(gw * 2 + s) + 55555u); int tok = id & 32767; const int j = (id >> 15) % DFF; const int md = (id >> 28) & 7;
            if (md == 1) tok = (tok & ~255) + 7; if (md == 2) tok = (tok & ~255) + 8; if (md == 3) tok = (tok & ~255) + 63; if (md == 4) tok = (tok & ~255) + 3; if (md == 5) tok = (tok & ~255) + 64;
            const int rowg = (j >> 7) * 256 + (j & 127); float cg = b_conv[j], cv = b_conv[DFF + j];
            for (int d = -1; d <= 1; ++d) { const int r = tok + d; if ((r >> 12) != (tok >> 12) || r < 0) continue;
                float ssum = 0.f; for (int i = 0; i < 16; ++i) ssum += SS1[(size_t)r * 16 + i]; const float rstd = rsqrtf(ssum * (1.0f / 1024.0f) + 1e-6f);
                const float ug = rstd * wdot_bf(XB2 + (size_t)r * 1024, WUP + (size_t)rowg * 1024, 1024, lane), uv = rstd * wdot_bf(XB2 + (size_t)r * 1024, WUP + (size_t)(rowg + 128) * 1024, 1024, lane);
                cg += w_conv[(size_t)(d + 1) * NUP + j] * ug; cv += w_conv[(size_t)(d + 1) * NUP + DFF + j] * uv; }
            const float want = cg / (1.0f + __expf(-cg)) * cv, got = bf2f(GB[(size_t)tok * DFF + j]); acc_err(E, 5, (got - want) * (got - want), want * want, lane); acc_err(E, 40 + (md > 5 ? 0 : md), (got - want) * (got - want), want * want, lane); }
    }
    asm volatile("s_waitcnt vmcnt(0) lgkmcnt(0)" ::: "memory"); grid.sync();
#endif
    { pg8::Gemm g{GB, WDOWN, MTOK, 1024, DFF}; pg8::StaticOrder S; S.init(MTOK, 1024, G, bid); pg8::EpiRes E{out, out, nullptr, SS2, ABL_FFN};
      pg8::gemm_phase<pg8::EpiRes, pg8::StaticOrder, true, true, false>(lds, g, S, E); }
    asm volatile("s_waitcnt vmcnt(0) lgkmcnt(0)" ::: "memory"); grid.sync();
    { FRESH();
    for (int m = gw; m < MTOK; m += NGW) { f32x4* xr = (f32x4*)(out + (size_t)m * DM) + lane; const float sp = lane < 16 ? SS2[(size_t)m * 16 + lane] : 0.f;
        const float rstd = __builtin_amdgcn_rsqf(wave_sum(sp) * (1.0f / DM) + 1e-6f);
#pragma unroll
        for (int j = 0; j < 4; ++j) { const f32x4 gf = ((const f32x4*)g_final)[lane + 64 * j]; const f32x4 v = xr[64 * j]; xr[64 * j] = v * rstd * gf; } } }

#if PROBE
    asm volatile("s_waitcnt vmcnt(0) lgkmcnt(0)" ::: "memory"); grid.sync();
    { FRESH(); const float* E = (const float*)(ws + 4096); float code;
      if (PROBE == 2) { int mask = 0; for (int h = 0; h < 6; ++h) { const float f1 = E[2 * (10 + 2 * h)] / E[2 * (10 + 2 * h) + 1], f0 = E[2 * (11 + 2 * h)] / E[2 * (11 + 2 * h) + 1]; if (f1 > 0.8f && f0 < 0.2f) mask |= 1 << h; } code = (float)mask; }
      else if (PROBE == 3) { int mask = 0; for (int h = 0; h < 6; ++h) { const float f1 = E[2 * (10 + 2 * h)] / E[2 * (10 + 2 * h) + 1], f0 = E[2 * (11 + 2 * h)] / E[2 * (11 + 2 * h) + 1]; if (f0 > 0.8f && f1 < 0.2f) mask |= 1 << h; } code = (float)mask; }
      else if (PROBE == 4) { int mask = 0; const float fl = (float)lane;
          if (pg8::xsum<1>(fl) != (float)(lane + (lane ^ 1))) mask |= 1; if (pg8::xsum<2>(fl) != (float)(lane + (lane ^ 2))) mask |= 2; if (pg8::xsum<4>(fl) != (float)(lane + (lane ^ 4))) mask |= 4;
          if (pg8::xsum<8>(fl) != (float)(lane + (lane ^ 8))) mask |= 8; if (pg8::xsum<16>(fl) != (float)(lane + (lane ^ 16))) mask |= 16; if (pg8::xsum<32>(fl) != (float)(lane + (lane ^ 32))) mask |= 32;
          mask = __any(mask & 1) * 1 + __any(mask & 2) * 2 + __any(mask & 4) * 4 + __any(mask & 8) * 8 + __any(mask & 16) * 16 + __any(mask & 32) * 32; code = (float)mask; }
      else if (PROBE == 5) { int mask = 0; for (int i = 0; i < 6; ++i) if (!(E[2 * (40 + i)] <= 3e-3f * E[2 * (40 + i) + 1])) mask |= 1 << i; code = (float)mask; }
      else if (PROBE == 6) { int mask = 0; const int fr = lane & 15;
          const int a = __builtin_amdgcn_update_dpp(0, lane + 100, 0x111, 0xf, 0xf, true), b = __builtin_amdgcn_update_dpp(0, lane + 100, 0x101, 0xf, 0xf, true);
          if (a != (fr == 0 ? 0 : lane + 99)) mask |= 1; if (b != (fr == 15 ? 0 : lane + 101)) mask |= 2; if (a == (fr == 15 ? 0 : lane + 101)) mask |= 4; if (b == (fr == 0 ? 0 : lane + 99)) mask |= 8;
          mask = __any(mask & 1) * 1 + __any(mask & 2) * 2 + __all(mask & 4) * 4 + __all(mask & 8) * 8; code = (float)mask; }
      else if (PROBE == 1) { int mask = 0; for (int i = 0; i < 6; ++i) if (!(E[2 * i] <= 3e-3f * E[2 * i + 1])) mask |= 1 << i; code = (float)mask; }
      else { const int i = PROBE - 10; code = 1e6f * E[2 * i] / E[2 * i + 1]; }
      const float kk = sqrtf(code);
      for (int e = gt; e < MTOK * DM / 4; e += NGT) ((f32x4*)out)[e] = (f32x4){kk, kk, kk, kk}; }
#endif
}

extern "C" void kernel_launch(void* const* d_in, const int* in_sizes, int n_in, void* d_out, int out_size, void* d_ws, size_t ws_size, hipStream_t stream) {
    static int grid = 0;
    if (grid == 0) {
        if (n_in != 16 || out_size != MTOK * DM || ws_size < WS_END) { fprintf(stderr, "kernel_launch: unexpected shapes (n_in %d out %d ws %zu)\n", n_in, out_size, ws_size); grid = -1; return; }
        int dev = 0, cus = 0, per_cu = 0;
        hipGetDevice(&dev); hipDeviceGetAttribute(&cus, hipDeviceAttributeMultiprocessorCount, dev);
        hipFuncSetAttribute((const void*)fwd_mega, hipFuncAttributeMaxDynamicSharedMemorySize, LDS_BYTES);
        hipOccupancyMaxActiveBlocksPerMultiprocessor(&per_cu, (const void*)fwd_mega, NWAVES * 64, LDS_BYTES);
        if (per_cu < 1) { fprintf(stderr, "kernel_launch: occupancy query says %d blocks per CU\n", per_cu); per_cu = 1; }
        (void)hipGetLastError();
        grid = cus;
    }
    if (grid < 0) return;
    Args a{};
    for (int i = 0; i < 16; ++i) a.in[i] = (const float*)d_in[i];
    a.out = (float*)d_out; a.ws = (unsigned char*)d_ws;
    void* kargs[] = {&a};
    hipError_t e = hipLaunchCooperativeKernel((const void*)fwd_mega, dim3(grid), dim3(NWAVES * 64), kargs, LDS_BYTES, stream);
    if (e != hipSuccess) fprintf(stderr, "cooperative launch failed: %s (grid %d)\n", hipGetErrorString(e), grid);
}
```

```cpp
#include <hip/hip_runtime.h>
#include <hip/hip_cooperative_groups.h>
#include <cstdio>
#include <cstdint>
namespace cg = cooperative_groups;
#ifndef ABL_FFN
#define ABL_FFN 1.0f
#endif
#ifndef ABL_ATT
#define ABL_ATT 1.0f
#endif
#ifndef ABL_FT
#define ABL_FT 1.0f
#endif
#ifndef REP_P0
#define REP_P0 1
#endif
#ifndef REP_P1
#define REP_P1 1
#endif
#ifndef REP_ATT
#define REP_ATT 1
#endif
#ifndef REP_DFT
#define REP_DFT 1
#endif
#ifndef REP_P3
#define REP_P3 1
#endif
#ifndef REP_P4
#define REP_P4 1
#endif
#ifndef REP_P0A
#define REP_P0A 1
#endif
#ifndef REP_P0B
#define REP_P0B 1
#endif
#ifndef REP_P0C
#define REP_P0C 1
#endif
#ifndef REP_P0F
#define REP_P0F 1
#endif
#ifndef REP_P5
#define REP_P5 1
#endif
#ifndef FORCE_UNFUSED
#define FORCE_UNFUSED 0
#endif
#ifndef P5_SP2
#define P5_SP2 true
#endif
#ifndef P5_ALIGN
#define P5_ALIGN true
#endif
namespace pg8 {
#define PG8_LAS __attribute__((address_space(3)))
typedef unsigned short bf16_t;
typedef short bf16x8 __attribute__((ext_vector_type(8)));
typedef float f32x4 __attribute__((ext_vector_type(4)));
typedef unsigned u32x4 __attribute__((ext_vector_type(4)));
constexpr int BM = 256, BK = 64, HALF = 128, HTB = HALF * BK * 2  , STAGE_BYTES = 8 * HTB, NXCD = 8, WGM = 8;

__host__ __device__ __forceinline__ int lds_byte(int r, int c) { const int st = (r >> 4) * 2 + (c >> 5), rr = r & 15, cc = c & 31, ob = rr * 64 + cc * 2; return st * 1024 + (ob ^ (((ob >> 9) & 1) << 5)); }
__host__ __device__ __forceinline__ void stage_rc(int b, int& R, int& C) { const int st = b / 1024, sb = b % 1024, swz = sb ^ (((sb >> 9) & 1) << 5); R = (st >> 1) * 16 + swz / 64; C = (st & 1) * 32 + (swz % 64) / 2; }
__host__ __device__ __forceinline__ int perm32(int rho) { const int n = rho >> 4, i = rho & 15; return 8 * (i >> 2) + 4 * n + (i & 3); }

struct Unit { int pm, pn; };
struct Gemm { const bf16_t* A; const bf16_t* Bt; int M, N, K; const bf16_t* Bt2 = nullptr; int pm_split = 1 << 30; };

struct StaticOrder {
    int nM, nN, nwg, G, c;
    __host__ __device__ void init(int M, int N, int G_, int c_) { nM = M / BM; nN = N / BM; nwg = nM * nN; G = G_; c = c_; }
    __host__ __device__ bool next(int i, Unit& u) const {
        const long L = (long)i * G + c; if (L >= nwg) return false;
        int wgid = (int)L; { const int q = nwg / NXCD, r = nwg % NXCD, xcd = wgid % NXCD, off = wgid / NXCD; wgid = (xcd < r ? xcd * (q + 1) : r * (q + 1) + (xcd - r) * q) + off; }
        const int nig = WGM * nN, gid = wgid / nig, fm = gid * WGM, gsz = (nM - fm) < WGM ? (nM - fm) : WGM;
        u.pm = fm + ((wgid % nig) % gsz); u.pn = (wgid % nig) / gsz; return true;
    }
    __device__ __forceinline__ void a_ready(const Unit&) const {}
    __device__ __forceinline__ void done(const Unit&) const {}
};

__device__ __forceinline__ unsigned cvt_pk_bf16(float lo, float hi) { unsigned r; asm volatile("v_cvt_pk_bf16_f32 %0, %1, %2" : "=v"(r) : "v"(lo), "v"(hi)); return r; }

template <int K> __device__ __forceinline__ float xsum(float v) {
    if constexpr (K == 32) { float a = v, b = v;
        asm volatile("s_nop 1\n\tv_permlane32_swap_b32 %0, %1" : "+v"(a), "+v"(b)); return a + b; }
    else return v + __builtin_bit_cast(float, __builtin_amdgcn_ds_swizzle(__builtin_bit_cast(int, v), (K << 10) | 0x1f));
}
typedef float f32x2 __attribute__((ext_vector_type(2)));
struct EpiStore {
    static constexpr bool PERM = true, AFTER_DRAIN = false;
    bf16_t* O; bf16_t* O2; bf16_t* O3; int ldc; float scale; int mode;
    __device__ __forceinline__ void operator()(f32x4 (&acc)[2][2][4][2], const Unit& u, int wr, int wc, int fr, int fq) const {
        bf16_t* base = O; int ld = ldc; int row0, col0;
        if (mode == 0) { row0 = u.pm * BM; col0 = u.pn * BM; }
        else if (mode == 1) { row0 = (u.pn >> 1) * 4096 + u.pm * BM; col0 = 512 + (u.pn & 1) * BM; }
        else { const int sec = u.pm >> 1, b = u.pn >> 4, s0 = (u.pn & 15) * BM; row0 = b * 512 + (u.pm & 1) * BM;
               base = sec == 0 ? O : sec == 1 ? O2 : O3; ld = 4096; col0 = s0; }
        row0 += wr * 64 + fr; col0 += wc * 32 + 8 * fq;
        const float sc = scale;
#pragma unroll
        for (int ai = 0; ai < 2; ++ai)
#pragma unroll
            for (int m = 0; m < 4; ++m) { bf16_t* rowp = base + (size_t)(row0 + ai * HALF + m * 16) * ld + col0;
#pragma unroll
                for (int bj = 0; bj < 2; ++bj) { const f32x4 v0 = acc[ai][bj][m][0] * sc, v1 = acc[ai][bj][m][1] * sc;
                    u32x4 w; w.x = cvt_pk_bf16(v0[0], v0[1]); w.y = cvt_pk_bf16(v0[2], v0[3]); w.z = cvt_pk_bf16(v1[0], v1[1]); w.w = cvt_pk_bf16(v1[2], v1[3]);
                    *(u32x4*)(rowp + bj * HALF) = w; } }
    }
};

struct DftOrder {
    int G, c;
    __device__ __forceinline__ bool next(int i, Unit& u) const { const int L = i * G + c; if (L >= 256) return false; if (L < 128) { u.pm = L >> 4; u.pn = L & 15; } else { u.pm = 8 + ((L - 128) >> 4); u.pn = L & 15; } return true; }
    __device__ __forceinline__ void a_ready(const Unit&) const {}
    __device__ __forceinline__ void done(const Unit&) const {}
};
struct EpiDft {
    static constexpr bool PERM = true, AFTER_DRAIN = false;
    float* Pbuf; unsigned* flags; bf16_t* MIX; float scale;
    __device__ __forceinline__ void operator()(f32x4 (&acc)[2][2][4][2], const Unit& u, int wr, int wc, int fr, int fq) const {
        const int colt = wc * 32 + 8 * fq;
        if (u.pm < 8) {
            float* pb = Pbuf + (size_t)(u.pm * BM + wr * 64 + fr) * 4096 + u.pn * BM + colt;
#pragma unroll
            for (int ai = 0; ai < 2; ++ai)
#pragma unroll
                for (int m = 0; m < 4; ++m)
#pragma unroll
                    for (int bj = 0; bj < 2; ++bj) { float* q = pb + (size_t)(ai * HALF + m * 16) * 4096 + bj * HALF; *(f32x4*)q = acc[ai][bj][m][0]; *(f32x4*)(q + 4) = acc[ai][bj][m][1]; }
            asm volatile("s_waitcnt vmcnt(0)\n\ts_barrier" ::: "memory");
            if (threadIdx.x == 0) { __builtin_amdgcn_fence(__ATOMIC_RELEASE, "agent"); asm volatile("s_waitcnt vmcnt(0)" ::: "memory");
                __hip_atomic_store(flags + u.pm * 16 + u.pn, 1u, __ATOMIC_RELAXED, __HIP_MEMORY_SCOPE_AGENT); }
        } else {
            const int pmq = u.pm - 8; unsigned* fl = flags + pmq * 16 + u.pn;
            for (unsigned sp = 0; sp < (1u << 22); ++sp) { if (__hip_atomic_load(fl, __ATOMIC_RELAXED, __HIP_MEMORY_SCOPE_AGENT) != 0u) break; __builtin_amdgcn_s_sleep(4); }
            __builtin_amdgcn_fence(__ATOMIC_ACQUIRE, "agent"); asm volatile("s_waitcnt vmcnt(0)" ::: "memory");
            asm volatile("s_barrier" ::: "memory");
            const int b = u.pn >> 1, c0 = 512 + (u.pn & 1) * BM + colt; const int s0 = pmq * BM + wr * 64 + fr;
            const float* pb = Pbuf + (size_t)s0 * 4096 + u.pn * BM + colt; const float sc = scale;
#pragma unroll
            for (int ai = 0; ai < 2; ++ai)
#pragma unroll
                for (int m = 0; m < 4; ++m) { const int s = s0 + ai * HALF + m * 16; bf16_t* r0 = MIX + (size_t)(b * 4096 + s) * 1024 + c0; bf16_t* r1 = MIX + (size_t)(b * 4096 + (s ? 4096 - s : 0)) * 1024 + c0;
#pragma unroll
                    for (int bj = 0; bj < 2; ++bj) { const float* q = pb + (size_t)(ai * HALF + m * 16) * 4096 + bj * HALF; const f32x4 p0 = *(const f32x4*)q, p1 = *(const f32x4*)(q + 4);
                        const f32x4 a0 = (p0 - acc[ai][bj][m][0]) * sc, a1 = (p1 - acc[ai][bj][m][1]) * sc, b0 = (p0 + acc[ai][bj][m][0]) * sc, b1 = (p1 + acc[ai][bj][m][1]) * sc;
                        u32x4 w; w.x = cvt_pk_bf16(a0[0], a0[1]); w.y = cvt_pk_bf16(a0[2], a0[3]); w.z = cvt_pk_bf16(a1[0], a1[1]); w.w = cvt_pk_bf16(a1[2], a1[3]); *(u32x4*)(r0 + bj * HALF) = w;
                        if (s) { u32x4 v; v.x = cvt_pk_bf16(b0[0], b0[1]); v.y = cvt_pk_bf16(b0[2], b0[3]); v.z = cvt_pk_bf16(b1[0], b1[1]); v.w = cvt_pk_bf16(b1[2], b1[3]); *(u32x4*)(r1 + bj * HALF) = v; } } }
        }
    }
};
struct EpiRes {
    static constexpr bool PERM = false, AFTER_DRAIN = false;
    const float* base; const bf16_t* bbase; float* out; bf16_t* xb; float* ss; float accscale;
    __device__ __forceinline__ void operator()(f32x4 (&acc)[2][2][4][2], const Unit& u, int wr, int wc, int fr, int fq) const {
        typedef unsigned u32x2v __attribute__((ext_vector_type(2)));
        const int col0 = u.pn * BM + wc * 32 + 4 * fq;
#pragma unroll
        for (int ai = 0; ai < 2; ++ai)
#pragma unroll
            for (int mp = 0; mp < 2; ++mp) {
                f32x4 bs[2][2][2];
#pragma unroll
                for (int mm = 0; mm < 2; ++mm) { const int m = 2 * mp + mm; const int row = u.pm * BM + ai * HALF + wr * 64 + m * 16 + fr; const size_t off = (size_t)row * 1024 + col0;
#pragma unroll
                    for (int bj = 0; bj < 2; ++bj)
#pragma unroll
                        for (int n = 0; n < 2; ++n) {
                            if (base) bs[mm][bj][n] = *(const f32x4*)(base + off + bj * HALF + n * 16);
                            else { const u32x2v w = *(const u32x2v*)(bbase + off + bj * HALF + n * 16); bs[mm][bj][n] = (f32x4){__builtin_bit_cast(float, w.x << 16), __builtin_bit_cast(float, w.x & 0xffff0000u), __builtin_bit_cast(float, w.y << 16), __builtin_bit_cast(float, w.y & 0xffff0000u)}; } } }
                asm volatile("" ::: "memory");
#pragma unroll
                for (int mm = 0; mm < 2; ++mm) { const int m = 2 * mp + mm; const int row = u.pm * BM + ai * HALF + wr * 64 + m * 16 + fr; const size_t off = (size_t)row * 1024 + col0; float q = 0.f;
#pragma unroll
                    for (int bj = 0; bj < 2; ++bj)
#pragma unroll
                        for (int n = 0; n < 2; ++n) { const f32x4 o = bs[mm][bj][n] + acc[ai][bj][m][n] * accscale;
                            if (out) *(f32x4*)(out + off + bj * HALF + n * 16) = o;
                            q += (o[0] * o[0] + o[1] * o[1]) + (o[2] * o[2] + o[3] * o[3]);
                            if (xb) { u32x2v w; w.x = cvt_pk_bf16(o[0], o[1]); w.y = cvt_pk_bf16(o[2], o[3]); *(u32x2v*)(xb + off + bj * HALF + n * 16) = w; } }
                    q = xsum<16>(q); q = xsum<32>(q);
                    if (fq == 0) ss[(size_t)row * 16 + u.pn * 4 + wc] = q; }
            }
    }
};
struct EpiResNorm {
    static constexpr bool PERM = false, AFTER_DRAIN = false;
    const bf16_t* bbase; float* out; float* ss; unsigned* cnt; const float* gfin; float accscale;
    __device__ __forceinline__ void operator()(f32x4 (&acc)[2][2][4][2], const Unit& u, int wr, int wc, int fr, int fq) const {
        typedef unsigned u32x2v __attribute__((ext_vector_type(2)));
        const int col0 = u.pn * BM + wc * 32 + 4 * fq;
#pragma unroll
        for (int ai = 0; ai < 2; ++ai)
#pragma unroll
            for (int m = 0; m < 4; ++m) { const int row = u.pm * BM + ai * HALF + wr * 64 + m * 16 + fr; const size_t off = (size_t)row * 1024 + col0; float q = 0.f;
#pragma unroll
                for (int bj = 0; bj < 2; ++bj)
#pragma unroll
                    for (int n = 0; n < 2; ++n) { const u32x2v w = *(const u32x2v*)(bbase + off + bj * HALF + n * 16);
                        const f32x4 bs = (f32x4){__builtin_bit_cast(float, w.x << 16), __builtin_bit_cast(float, w.x & 0xffff0000u), __builtin_bit_cast(float, w.y << 16), __builtin_bit_cast(float, w.y & 0xffff0000u)};
                        const f32x4 o = bs + acc[ai][bj][m][n] * accscale; acc[ai][bj][m][n] = o; q += (o[0] * o[0] + o[1] * o[1]) + (o[2] * o[2] + o[3] * o[3]); }
                q = xsum<16>(q); q = xsum<32>(q);
                if (fq == 0) __hip_atomic_store(ss + (size_t)row * 16 + u.pn * 4 + wc, q, __ATOMIC_RELAXED, __HIP_MEMORY_SCOPE_AGENT); }
        asm volatile("s_waitcnt vmcnt(0)" ::: "memory");
        unsigned* pc = cnt + 16 * u.pm;
        if ((threadIdx.x & 63) == 0) __hip_atomic_fetch_add(pc, 1u, __ATOMIC_RELAXED, __HIP_MEMORY_SCOPE_AGENT);
        for (unsigned sp = 0; sp < (1u << 22); ++sp) { if (__hip_atomic_load(pc, __ATOMIC_RELAXED, __HIP_MEMORY_SCOPE_AGENT) >= 32u * rounds) break; __builtin_amdgcn_s_sleep(2); }
        __builtin_amdgcn_fence(__ATOMIC_ACQUIRE, "agent"); asm volatile("s_waitcnt vmcnt(0)" ::: "memory");
        f32x4 gf[2][2];
#pragma unroll
        for (int bj = 0; bj < 2; ++bj)
#pragma unroll
            for (int n = 0; n < 2; ++n) gf[bj][n] = *(const f32x4*)(gfin + col0 + bj * HALF + n * 16);
        float part[2][4][4];
#pragma unroll
        for (int ai = 0; ai < 2; ++ai)
#pragma unroll
            for (int m = 0; m < 4; ++m) { const int row = u.pm * BM + ai * HALF + wr * 64 + m * 16 + fr; const float* sp = ss + (size_t)row * 16 + 4 * fq;
#pragma unroll
                for (int e = 0; e < 4; ++e) part[ai][m][e] = __hip_atomic_load(sp + e, __ATOMIC_RELAXED, __HIP_MEMORY_SCOPE_AGENT); }
#pragma unroll
        for (int ai = 0; ai < 2; ++ai)
#pragma unroll
            for (int m = 0; m < 4; ++m) { const int row = u.pm * BM + ai * HALF + wr * 64 + m * 16 + fr; const size_t off = (size_t)row * 1024 + col0;
                float s = (part[ai][m][0] + part[ai][m][1]) + (part[ai][m][2] + part[ai][m][3]);
                s = xsum<16>(s); s = xsum<32>(s);
                const float rstd = __builtin_amdgcn_rsqf(s * (1.0f / 1024.0f) + 1e-6f);
#pragma unroll
                for (int bj = 0; bj < 2; ++bj)
#pragma unroll
                    for (int n = 0; n < 2; ++n) *(f32x4*)(out + off + bj * HALF + n * 16) = acc[ai][bj][m][n] * rstd * gf[bj][n]; }
    }
    unsigned rounds;
};
struct EpiConv {
    static constexpr bool PERM = true, AFTER_DRAIN = false;
    const float* ss; const float* wconv; const float* bconv; bf16_t* G; float* halo; PG8_LAS float* xch;
    __device__ __forceinline__ void operator()(f32x4 (&acc)[2][2][4][2], const Unit& u, int wr_, int wc_, int fr_, int fq_) const {
        int t_ = threadIdx.x; asm volatile("" : "+v"(t_));
        const int wid_ = __builtin_amdgcn_readfirstlane(t_ >> 6), wr = wid_ >> 2, wc = wid_ & 3, fr = t_ & 15, fq = (t_ >> 4) & 3; (void)wr_; (void)wc_; (void)fr_; (void)fq_;
        const int beta = 16 * wr + fr; const unsigned tok0 = (unsigned)(u.pm * BM + 8 * beta);
        float rs[8];
        { const char* sp = (const char*)ss + (size_t)((tok0 * 16u + 4u * (unsigned)fq) * 4u);
#pragma unroll
        for (int j = 0; j < 8; ++j) { const f32x4 a = *(const f32x4*)(sp + j * 64); float s = (a[0] + a[1]) + (a[2] + a[3]);
            s = xsum<16>(s); s = xsum<32>(s);
            rs[j] = __builtin_amdgcn_rsqf(s * (1.0f / 1024.0f) + 1e-6f); } }
#pragma unroll
        for (int ai = 0; ai < 2; ++ai)
#pragma unroll
            for (int m = 0; m < 4; ++m)
#pragma unroll
                for (int bj = 0; bj < 2; ++bj)
#pragma unroll
                    for (int n = 0; n < 2; ++n) acc[ai][bj][m][n] = acc[ai][bj][m][n] * rs[m + 4 * ai];
        if (fr == 0) { PG8_LAS f32x4* d = (PG8_LAS f32x4*)(xch + ((((wr * 4 + wc) * 2 + 0) * 4 + fq) * 16));
            d[0] = acc[0][0][0][0]; d[1] = acc[0][0][0][1]; d[2] = acc[0][1][0][0]; d[3] = acc[0][1][0][1]; }
        if (fr == 15) { PG8_LAS f32x4* d = (PG8_LAS f32x4*)(xch + ((((wr * 4 + wc) * 2 + 1) * 4 + fq) * 16));
            d[0] = acc[1][0][3][0]; d[1] = acc[1][0][3][1]; d[2] = acc[1][1][3][0]; d[3] = acc[1][1][3][1]; }
        if (beta == 0 || beta == 31) { const int hr = beta == 0 ? 0 : 2; char* hp = (char*)halo + (size_t)((((unsigned)u.pm * 4u + (unsigned)hr) * 5632u + (unsigned)(u.pn * BM + wc * 32 + 8 * fq)) * 4u);
#pragma unroll
            for (int t = 0; t < 2; ++t)
#pragma unroll
                for (int bj = 0; bj < 2; ++bj)
#pragma unroll
                    for (int n = 0; n < 2; ++n) *(f32x4*)(hp + (t * 5632 + bj * HALF + 4 * n) * 4) = beta == 0 ? acc[0][bj][t][n] : acc[1][bj][2 + t][n]; }
        asm volatile("s_waitcnt lgkmcnt(0)\n\ts_barrier" ::: "memory");
        const unsigned jg0 = (unsigned)(u.pn * 128 + wc * 32 + 8 * fq);
#pragma unroll
        for (int n = 0; n < 2; ++n)
#pragma unroll
            for (int bj = 0; bj < 2; ++bj) {
                const unsigned jc = (jg0 + 4u * n + bj * 2816u) * 4u;
                const f32x4 w0 = *(const f32x4*)((const char*)wconv + (size_t)jc), w1 = *(const f32x4*)((const char*)wconv + (size_t)(jc + 5632u * 4u)), w2 = *(const f32x4*)((const char*)wconv + (size_t)(jc + 2u * 5632u * 4u)), bb = *(const f32x4*)((const char*)bconv + (size_t)jc);
                f32x4 prv, nxt;
#pragma unroll
                for (int e = 0; e < 4; ++e) { float pa, na; const float sa = acc[1][bj][3][n][e], sb = acc[0][bj][0][n][e];
                    asm volatile("s_nop 1\n\tv_mov_b32_dpp %0, %2 row_shr:1 row_mask:0xf bank_mask:0xf bound_ctrl:1\n\tv_mov_b32_dpp %1, %3 row_shl:1 row_mask:0xf bank_mask:0xf bound_ctrl:1" : "=&v"(pa), "=&v"(na) : "v"(sa), "v"(sb));
                    prv[e] = pa; nxt[e] = na; }
                if (fr == 0) { if (wr == 1) prv = *(const PG8_LAS f32x4*)(xch + ((((0 * 4 + wc) * 2 + 1) * 4 + fq) * 16) + bj * 8 + n * 4); }
                if (fr == 15) { if (wr == 0) nxt = *(const PG8_LAS f32x4*)(xch + ((((1 * 4 + wc) * 2 + 0) * 4 + fq) * 16) + bj * 8 + n * 4); }
                f32x4 old = prv;
#pragma unroll
                for (int j = 0; j < 8; ++j) { const f32x4 cu = acc[j >> 2][bj][j & 3][n]; const f32x4 dn = j == 7 ? nxt : acc[(j + 1) >> 2][bj][(j + 1) & 3][n];
                    acc[j >> 2][bj][j & 3][n] = w0 * old + w1 * cu + w2 * dn + bb; old = cu; }
            }
        unsigned goff = (tok0 * 2816u + jg0) * 2u;
#pragma unroll
        for (int j = 0; j < 8; ++j) { unsigned w[4];
#pragma unroll
            for (int n = 0; n < 2; ++n) { const f32x4 g = acc[j >> 2][0][j & 3][n], v = acc[j >> 2][1][j & 3][n]; float r[4];
#pragma unroll
                for (int e = 0; e < 4; ++e) r[e] = g[e] * __builtin_amdgcn_rcpf(1.0f + __builtin_amdgcn_exp2f(-1.4426950408889634f * g[e])) * v[e];
                w[2 * n] = cvt_pk_bf16(r[0], r[1]); w[2 * n + 1] = cvt_pk_bf16(r[2], r[3]); }
            *(u32x4*)((char*)G + (size_t)goff) = (u32x4){w[0], w[1], w[2], w[3]}; goff += 5632u; }
    }
};
template <class Epi, class Sched, bool ALIGN_EPI = false, bool SP2 = false, bool APERM = false>
__device__ __forceinline__ void gemm_phase(PG8_LAS unsigned char* lds, const Gemm g, const Sched& S, const Epi& E) {
    int tid = threadIdx.x; asm volatile("" : "+v"(tid)); const int wid = __builtin_amdgcn_readfirstlane(tid >> 6), lane = tid & 63, wr = wid >> 2, wc = wid & 3, fr = lane & 15, fq = lane >> 4;
    const int K = g.K, nt = K / BK;
    unsigned voffA[2], voffB[2];
#pragma unroll
    for (int i = 0; i < 2; ++i) { int R, C; stage_rc(tid * 16 + i * 8192, R, C); const int Rb = Epi::PERM ? ((R & ~31) + perm32(R & 31)) : R;
        const int Ra = APERM ? (8 * (16 * ((R >> 6) & 1) + (R & 15)) + ((R >> 4) & 3)) : R; voffA[i] = (unsigned)(Ra * K + C) * 2u; voffB[i] = (unsigned)(Rb * K + C) * 2u; }
    const size_t voffA_d = (size_t)(APERM ? 128 : 64) * K * 2, voffB_d = (size_t)64 * K * 2;
    const size_t kstep = (size_t)(BK * 2);
    const size_t hstep = (size_t)HALF * K * 2;
    const size_t tstep = 2 * hstep; const size_t hstepA = APERM ? (size_t)4 * K * 2 : hstep;
    const unsigned ldsw = (unsigned)wid * 1024u;
    const int aoff = lds_byte(wr * 64 + fr, fq * 8), boff = lds_byte(wc * 32 + fr, fq * 8);
#define PG8_SA(b, h) (((b) * 2 + (h)) * HTB)
#define PG8_SB(b, h) ((4 + (b) * 2 + (h)) * HTB)
#define PG8_STAGE(bufoff, gbase, voff) do { _Pragma("unroll") for (int _i = 0; _i < 2; ++_i) \
        __builtin_amdgcn_global_load_lds((const unsigned*)((const char*)(gbase) + (size_t)_i * voff##_d + (voff)[0]), (PG8_LAS unsigned*)(lds + (bufoff) + ldsw + _i * 8192), 16, 0, 0); } while (0)
#define PG8_LDA(dst, b, h) do { _Pragma("unroll") for (int m = 0; m < 4; ++m) _Pragma("unroll") for (int k = 0; k < 2; ++k) dst[m][k] = *(const PG8_LAS bf16x8*)(lds + PG8_SA(b, h) + aoff + m * 2048 + k * 1024); } while (0)
#define PG8_LDB(dst, b, h) do { _Pragma("unroll") for (int n = 0; n < 2; ++n) _Pragma("unroll") for (int k = 0; k < 2; ++k) dst[n][k] = *(const PG8_LAS bf16x8*)(lds + PG8_SB(b, h) + boff + n * 2048 + k * 1024); } while (0)
#define PG8_MMA(ai, bj, At, Bt) do { __builtin_amdgcn_s_setprio(1); _Pragma("unroll") for (int m = 0; m < 4; ++m) _Pragma("unroll") for (int n = 0; n < 2; ++n) _Pragma("unroll") for (int k = 0; k < 2; ++k) \
        acc[ai][bj][m][n] = __builtin_amdgcn_mfma_f32_16x16x32_bf16(Bt[n][k], At[m][k], acc[ai][bj][m][n], 0, 0, 0); __builtin_amdgcn_s_setprio(0); } while (0)
#define PG8_WAIT_V(n) asm volatile("s_waitcnt vmcnt(" #n ")" ::: "memory")
#define PG8_WAIT_L(n) asm volatile("s_waitcnt lgkmcnt(" #n ")" ::: "memory")
#define PG8_BAR __builtin_amdgcn_s_barrier()
#define PG8_SCHED __builtin_amdgcn_sched_barrier(0)
    Unit cur, nxt; int ui = 0;
    if (!S.next(0, cur)) return;
    f32x4 acc[2][2][4][2];
#pragma unroll
    for (int a = 0; a < 2; ++a)
#pragma unroll
        for (int b = 0; b < 2; ++b)
#pragma unroll
            for (int m = 0; m < 4; ++m)
#pragma unroll
                for (int n = 0; n < 2; ++n) acc[a][b][m][n] = (f32x4){0.f, 0.f, 0.f, 0.f};
    bf16x8 At[4][2], B0[2][2], B1[2][2];
    const char* cA = (const char*)g.A + (size_t)cur.pm * tstep; const char* cB = (const char*)(cur.pm >= g.pm_split ? g.Bt2 : g.Bt) + (size_t)cur.pn * tstep;
    S.a_ready(cur);
    if constexpr (SP2) {
        PG8_STAGE(PG8_SB(0, 0), cB, voffB); PG8_STAGE(PG8_SB(0, 1), cB + hstep, voffB); PG8_STAGE(PG8_SA(0, 0), cA, voffA); PG8_STAGE(PG8_SA(0, 1), cA + hstepA, voffA);
        if (wr == 1) PG8_BAR;
        PG8_WAIT_V(2); PG8_BAR;
        PG8_STAGE(PG8_SB(1, 0), cB + kstep, voffB); PG8_STAGE(PG8_SA(1, 0), cA + kstep, voffA); PG8_STAGE(PG8_SB(1, 1), cB + hstep + kstep, voffB);
        PG8_WAIT_V(6); PG8_BAR;
    } else {
        PG8_STAGE(PG8_SB(0, 0), cB, voffB); PG8_STAGE(PG8_SA(0, 0), cA, voffA); PG8_STAGE(PG8_SB(0, 1), cB + hstep, voffB); PG8_STAGE(PG8_SA(0, 1), cA + hstepA, voffA);
        if (wr == 1) PG8_BAR;
        PG8_WAIT_V(4); PG8_BAR;
        PG8_STAGE(PG8_SB(1, 0), cB + kstep, voffB); PG8_STAGE(PG8_SA(1, 0), cA + kstep, voffA); PG8_STAGE(PG8_SB(1, 1), cB + hstep + kstep, voffB);
        PG8_WAIT_V(6); PG8_BAR;
    }
    for (;;) {
        const bool has_next = S.next(ui + 1, nxt);
        const char* nA = has_next ? (const char*)g.A + (size_t)nxt.pm * tstep : cA; const char* nB = has_next ? (const char*)(nxt.pm >= g.pm_split ? g.Bt2 : g.Bt) + (size_t)nxt.pn * tstep : cB;
        for (int t = 0; t < nt; t += 2) {
            const bool last = (t == nt - 2);
            const char* a1 = cA + (size_t)(t + 1) * kstep;
            const char* a2 = last ? nA : cA + (size_t)(t + 2) * kstep; const char* b2 = last ? nB : cB + (size_t)(t + 2) * kstep;
            const char* a3 = a2 + kstep; const char* b3 = b2 + kstep;
            if (last && has_next) S.a_ready(nxt);
            if constexpr (SP2) {
            PG8_LDB(B0, 0, 0); PG8_LDB(B1, 0, 1); PG8_SCHED; PG8_LDA(At, 0, 0); PG8_STAGE(PG8_SA(1, 1), a1 + hstepA, voffA);
            PG8_WAIT_V(8); PG8_WAIT_L(0); PG8_BAR; PG8_MMA(0, 0, At, B0); PG8_MMA(0, 1, At, B1); PG8_BAR; PG8_SCHED;
            PG8_LDA(At, 0, 1); PG8_STAGE(PG8_SB(0, 0), b2, voffB); PG8_STAGE(PG8_SB(0, 1), b2 + hstep, voffB); PG8_STAGE(PG8_SA(0, 0), a2, voffA);
            PG8_WAIT_V(8); PG8_WAIT_L(0); PG8_BAR; PG8_MMA(1, 0, At, B0); PG8_MMA(1, 1, At, B1); PG8_BAR; PG8_SCHED;
            PG8_LDB(B0, 1, 0); PG8_LDB(B1, 1, 1); PG8_SCHED; PG8_LDA(At, 1, 0); PG8_STAGE(PG8_SA(0, 1), a2 + hstepA, voffA);
            PG8_WAIT_V(8); PG8_WAIT_L(0); PG8_BAR; PG8_MMA(0, 0, At, B0); PG8_MMA(0, 1, At, B1); PG8_BAR; PG8_SCHED;
            PG8_LDA(At, 1, 1); PG8_STAGE(PG8_SB(1, 0), b3, voffB); PG8_STAGE(PG8_SB(1, 1), b3 + hstep, voffB); PG8_STAGE(PG8_SA(1, 0), a3, voffA);
            PG8_WAIT_V(8); PG8_WAIT_L(0); PG8_BAR; PG8_MMA(1, 0, At, B0); PG8_MMA(1, 1, At, B1); PG8_BAR; PG8_SCHED;
            } else {
            PG8_LDB(B0, 0, 0); PG8_SCHED; PG8_LDA(At, 0, 0); PG8_STAGE(PG8_SA(1, 1), a1 + hstepA, voffA);
            PG8_WAIT_L(8); PG8_BAR; PG8_WAIT_L(0); PG8_MMA(0, 0, At, B0); PG8_BAR; PG8_SCHED;
            PG8_LDB(B1, 0, 1); PG8_STAGE(PG8_SB(0, 0), b2, voffB);
            PG8_BAR; PG8_WAIT_L(0); PG8_MMA(0, 1, At, B1); PG8_BAR;
            PG8_LDA(At, 0, 1); PG8_STAGE(PG8_SA(0, 0), a2, voffA);
            PG8_BAR; PG8_WAIT_L(0); PG8_MMA(1, 0, At, B0); PG8_BAR; PG8_SCHED;
            PG8_STAGE(PG8_SB(0, 1), b2 + hstep, voffB);
            PG8_WAIT_V(6); PG8_BAR; PG8_MMA(1, 1, At, B1); PG8_BAR;
            PG8_LDB(B0, 1, 0); PG8_SCHED; PG8_LDA(At, 1, 0); PG8_STAGE(PG8_SA(0, 1), a2 + hstepA, voffA);
            PG8_WAIT_L(8); PG8_BAR; PG8_WAIT_L(0); PG8_MMA(0, 0, At, B0); PG8_BAR; PG8_SCHED;
            PG8_LDB(B1, 1, 1); PG8_STAGE(PG8_SB(1, 0), b3, voffB);
            PG8_BAR; PG8_WAIT_L(0); PG8_MMA(0, 1, At, B1); PG8_BAR;
            PG8_LDA(At, 1, 1); PG8_STAGE(PG8_SA(1, 0), a3, voffA);
            PG8_BAR; PG8_WAIT_L(0); PG8_MMA(1, 0, At, B0); PG8_BAR; PG8_SCHED;
            PG8_STAGE(PG8_SB(1, 1), b3 + hstep, voffB);
            PG8_WAIT_V(6); PG8_BAR; PG8_MMA(1, 1, At, B1); PG8_BAR;
            }
        }
        if constexpr (ALIGN_EPI) { if (wr == 0) PG8_BAR; }
        if constexpr (!Epi::AFTER_DRAIN) { E(acc, cur, wr, wc, fr, fq); S.done(cur); }
        if (!has_next) break;
#pragma unroll
        for (int a = 0; a < 2; ++a)
#pragma unroll
            for (int b = 0; b < 2; ++b)
#pragma unroll
                for (int m = 0; m < 4; ++m)
#pragma unroll
                    for (int n = 0; n < 2; ++n) acc[a][b][m][n] = (f32x4){0.f, 0.f, 0.f, 0.f};
        cur = nxt; cA = nA; cB = nB; ++ui;
        if constexpr (ALIGN_EPI) { if (wr == 1) PG8_BAR; }
    }
    PG8_WAIT_V(0);
    if constexpr (!ALIGN_EPI) { if (wr == 0) PG8_BAR; }
    PG8_BAR;
    if constexpr (Epi::AFTER_DRAIN) { E.fused(acc, cur, wr, wc, fr, fq, lds, wid, lane); S.done(cur); }
#undef PG8_SA
#undef PG8_SB
#undef PG8_STAGE
#undef PG8_LDA
#undef PG8_LDB
#undef PG8_MMA
#undef PG8_WAIT_V
#undef PG8_WAIT_L
#undef PG8_BAR
#undef PG8_SCHED
}
}
namespace att {
#define LAS __attribute__((address_space(3)))
typedef unsigned short bf16_t;
typedef short bf16x8 __attribute__((ext_vector_type(8)));
typedef short s16x4 __attribute__((ext_vector_type(4)));
typedef float f32x16 __attribute__((ext_vector_type(16)));
typedef float f32x4 __attribute__((ext_vector_type(4)));
typedef unsigned u32x2 __attribute__((ext_vector_type(2)));
constexpr int SEQ = 4096, KVB = 64, NT = SEQ / KVB, KBUFB = 16384, VOFFB = 32768, QOFFB = 65536;
constexpr float LOG2E = 1.4426950408889634f;
__device__ __forceinline__ unsigned cvtpk(float lo, float hi) { unsigned r; asm volatile("v_cvt_pk_bf16_f32 %0, %1, %2" : "=v"(r) : "v"(lo), "v"(hi)); return r; }
__device__ __forceinline__ float swapmax(float v) { float a = v, b = v; asm volatile("s_nop 1\n\tv_permlane32_swap_b32 %0, %1" : "+v"(a), "+v"(b)); return fmaxf(a, b); }
__device__ __forceinline__ float swapsum(float v) { float a = v, b = v; asm volatile("s_nop 1\n\tv_permlane32_swap_b32 %0, %1" : "+v"(a), "+v"(b)); return a + b; }


__device__ __forceinline__ void kmax_slice(LAS unsigned char* lds, const bf16_t* __restrict__ QK, unsigned* KSH, int bh, int slice) {
    const int tid = threadIdx.x, lane = tid & 63; const int wid = __builtin_amdgcn_readfirstlane(tid >> 6);
    const bf16_t* Kn = QK + (size_t)(bh >> 2) * SEQ * 1024 + 512 + (bh & 3) * 128 + (size_t)slice * 512 * 1024; float kn2 = 0.f;
    for (int i0 = 0; i0 < 16; i0 += 8) { bf16x8 kv16[8];
#pragma unroll
        for (int u = 0; u < 8; ++u) kv16[u] = *(const bf16x8*)(Kn + (size_t)((wid * 16 + i0 + u) * 4 + (lane >> 4)) * 1024 + (lane & 15) * 8);
#pragma unroll
        for (int u = 0; u < 8; ++u) { float a = 0.f;
#pragma unroll
            for (int e = 0; e < 8; ++e) { const float f = __builtin_bit_cast(float, (unsigned)(unsigned short)kv16[u][e] << 16); a += f * f; }
            a += __builtin_bit_cast(float, __builtin_amdgcn_ds_swizzle(__builtin_bit_cast(int, a), (1 << 10) | 0x1f)); a += __builtin_bit_cast(float, __builtin_amdgcn_ds_swizzle(__builtin_bit_cast(int, a), (2 << 10) | 0x1f));
            a += __builtin_bit_cast(float, __builtin_amdgcn_ds_swizzle(__builtin_bit_cast(int, a), (4 << 10) | 0x1f)); kn2 = fmaxf(kn2, a); } }
#define ATT_SWZMAX(v, K_) v = fmaxf(v, __builtin_bit_cast(float, __builtin_amdgcn_ds_swizzle(__builtin_bit_cast(int, v), ((K_) << 10) | 0x1f)))
    ATT_SWZMAX(kn2, 1); ATT_SWZMAX(kn2, 2); ATT_SWZMAX(kn2, 4); ATT_SWZMAX(kn2, 8); ATT_SWZMAX(kn2, 16);
#undef ATT_SWZMAX
    kn2 = swapmax(kn2);
    LAS float* red = (LAS float*)(lds + 131072);
    if (lane == 0) red[wid] = kn2;
    asm volatile("s_waitcnt lgkmcnt(0)\n\ts_barrier" ::: "memory");
    if (tid == 0) { float km = 0.f; for (int w = 0; w < 8; ++w) km = fmaxf(km, red[w]);
        __hip_atomic_fetch_max(KSH + bh, __builtin_bit_cast(unsigned, km), __ATOMIC_RELAXED, __HIP_MEMORY_SCOPE_AGENT);
        __builtin_amdgcn_fence(__ATOMIC_RELEASE, "agent"); asm volatile("s_waitcnt vmcnt(0)" ::: "memory");
        __hip_atomic_fetch_add(KSH + 64 + bh, 1u, __ATOMIC_RELAXED, __HIP_MEMORY_SCOPE_AGENT); }
    asm volatile("s_waitcnt lgkmcnt(0)\n\ts_barrier" ::: "memory");
}
__device__ __forceinline__ void attn_unit(LAS unsigned char* lds, const bf16_t* __restrict__ QK, const bf16_t* __restrict__ VT, bf16_t* __restrict__ MIX, const float* __restrict__ gsub, float lam, int b, int h, int qb, unsigned* KSH) {
    int tid = threadIdx.x; asm volatile("" : "+v"(tid));
    const int lane = tid & 63, r32 = lane & 31, hi = lane >> 5; const int wid = __builtin_amdgcn_readfirstlane(tid >> 6);
    const float slope2 = __builtin_amdgcn_exp2f(-2.0f * (float)(h + 1)) * LOG2E;
    const int qpos = qb * 256 + wid * 32 + r32;
    int t_lo, t_hi;
    { float kn2 = 0.f, qn2 = 0.f;
      const bf16_t* Kn = QK + (size_t)b * SEQ * 1024 + 512 + h * 128;
      if (!KSH) for (int i0 = 0; i0 < 128; i0 += 8) { bf16x8 kv16[8];
#pragma unroll
          for (int u = 0; u < 8; ++u) kv16[u] = *(const bf16x8*)(Kn + (size_t)((wid * 128 + i0 + u) * 4 + (lane >> 4)) * 1024 + (lane & 15) * 8);
#pragma unroll
          for (int u = 0; u < 8; ++u) { float a = 0.f;
#pragma unroll
              for (int e = 0; e < 8; ++e) { const float f = __builtin_bit_cast(float, (unsigned)(unsigned short)kv16[u][e] << 16); a += f * f; }
              a += __builtin_bit_cast(float, __builtin_amdgcn_ds_swizzle(__builtin_bit_cast(int, a), (1 << 10) | 0x1f)); a += __builtin_bit_cast(float, __builtin_amdgcn_ds_swizzle(__builtin_bit_cast(int, a), (2 << 10) | 0x1f));
              a += __builtin_bit_cast(float, __builtin_amdgcn_ds_swizzle(__builtin_bit_cast(int, a), (4 << 10) | 0x1f)); kn2 = fmaxf(kn2, a); } }
      float qa1 = 0.f, qa2 = 0.f, sd1 = 0.f, sd2 = 0.f;
      if (tid < 256) { const bf16x8* qr = (const bf16x8*)(QK + (size_t)(b * SEQ + qb * 256 + tid) * 1024 + h * 128); const bf16x8* kr = (const bf16x8*)(QK + (size_t)(b * SEQ + qb * 256 + tid) * 1024 + 512 + h * 128);
#pragma unroll
          for (int c = 0; c < 16; ++c) { const bf16x8 v = qr[c], w = kr[c]; float a = 0.f, d = 0.f;
#pragma unroll
              for (int e = 0; e < 8; ++e) { const float f = __builtin_bit_cast(float, (unsigned)(unsigned short)v[e] << 16), g = __builtin_bit_cast(float, (unsigned)(unsigned short)w[e] << 16); a += f * f; d += f * g; }
              if (c < 8) { qa1 += a; sd1 += d; } else { qa2 += a; sd2 += d; } } }
#define ATT_SWZMAX(v, K_) v = fmaxf(v, __builtin_bit_cast(float, __builtin_amdgcn_ds_swizzle(__builtin_bit_cast(int, v), ((K_) << 10) | 0x1f)))
      ATT_SWZMAX(kn2, 1); ATT_SWZMAX(kn2, 2); ATT_SWZMAX(kn2, 4); ATT_SWZMAX(kn2, 8); ATT_SWZMAX(kn2, 16);
      kn2 = swapmax(kn2);
      LAS float* red = (LAS float*)(lds + 131072);
      if (lane == 0) red[wid] = kn2;
      asm volatile("s_waitcnt lgkmcnt(0)\n\ts_barrier" ::: "memory");
      float km = 0.f;
#pragma unroll
      for (int w = 0; w < 8; ++w) km = fmaxf(km, red[w]);
      if (KSH) {
          unsigned* kc = KSH + 64 + (b * 4 + h);
          for (unsigned sp = 0; sp < (1u << 22); ++sp) { if (__hip_atomic_load(kc, __ATOMIC_RELAXED, __HIP_MEMORY_SCOPE_AGENT) >= 8u) break; __builtin_amdgcn_s_sleep(2); }
          __builtin_amdgcn_fence(__ATOMIC_ACQUIRE, "agent");
          km = __builtin_bit_cast(float, __hip_atomic_load(KSH + (b * 4 + h), __ATOMIC_RELAXED, __HIP_MEMORY_SCOPE_AGENT)); }
      float rr_ = tid < 256 ? fmaxf(sqrtf(qa1 * km) * 1.01f - sd1, sqrtf(qa2 * km) * 1.01f - sd2) : 0.f;
      if (tid < 256) { red[64 + tid] = fminf(sqrtf(qa1 * km) * 1.01f + 0.01f, sd1 + 100.0f); red[320 + tid] = fminf(sqrtf(qa2 * km) * 1.01f + 0.01f, sd2 + 100.0f); }
      ATT_SWZMAX(rr_, 1); ATT_SWZMAX(rr_, 2); ATT_SWZMAX(rr_, 4); ATT_SWZMAX(rr_, 8); ATT_SWZMAX(rr_, 16);
#undef ATT_SWZMAX
      rr_ = swapmax(rr_);
      if (lane == 0) red[8 + wid] = rr_;
      asm volatile("s_waitcnt lgkmcnt(0)\n\ts_barrier" ::: "memory");
      float rm = 0.f;
#pragma unroll
      for (int w = 0; w < 8; ++w) rm = fmaxf(rm, red[8 + w]);
      asm volatile("s_waitcnt lgkmcnt(0)\n\ts_barrier" ::: "memory");
      const float dm = (rm + 0.05f + 32.0f) / slope2;
      const int dmi = dm < 8192.0f ? (int)dm + 2 : 8192;
      const int q0 = qb * 256; int lo = q0 - dmi; if (lo < 0) lo = 0; int hk = q0 + 255 + dmi; if (hk > SEQ - 1) hk = SEQ - 1;
      t_lo = __builtin_amdgcn_readfirstlane(lo >> 6); t_hi = __builtin_amdgcn_readfirstlane(hk >> 6); }
    { const char* Qg = (const char*)(QK + (size_t)(b * SEQ + qb * 256 + wid * 32) * 1024 + h * 128);
#pragma unroll
      for (int p = 0; p < 8; ++p) { const int row = 4 * p + (lane >> 4); const int c = (lane & 15) ^ (row & 15);
          __builtin_amdgcn_global_load_lds((const unsigned*)(Qg + (size_t)(row * 2048 + c * 16)), (LAS unsigned*)(lds + QOFFB + wid * 8192 + p * 1024), 16, 0, 0); } }
    const char* Kg = (const char*)(QK + (size_t)b * SEQ * 1024 + 512 + h * 128);
    const char* Vg = (const char*)(VT + (size_t)(b * 512 + h * 128) * 4096);
    unsigned koff[2], voff[2];
#pragma unroll
    for (int i = 0; i < 2; ++i) { const int p = wid + 8 * i; const int row = 4 * p + (lane >> 4); const int c = (lane & 15) ^ (row & 15); koff[i] = (unsigned)(row * 2048 + c * 16);
        const int dv = 8 * p + (lane >> 3); const int j = (lane & 7) ^ ((dv >> 1) & 7); voff[i] = (unsigned)(dv * 8192 + j * 16); }
#define ATT_DMA(t, buf) do { _Pragma("unroll") for (int i_ = 0; i_ < 2; ++i_) { \
        __builtin_amdgcn_global_load_lds((const unsigned*)(Kg + (size_t)(t) * (KVB * 2048) + koff[i_]), (LAS unsigned*)(lds + (buf) * KBUFB + (wid + 8 * i_) * 1024), 16, 0, 0); \
        __builtin_amdgcn_global_load_lds((const unsigned*)(Vg + (size_t)(t) * (KVB * 2) + voff[i_]), (LAS unsigned*)(lds + VOFFB + (buf) * KBUFB + (wid + 8 * i_) * 1024), 16, 0, 0); } } while (0)
    f32x16 O[2][4];
#pragma unroll
    for (int c = 0; c < 2; ++c)
#pragma unroll
        for (int k = 0; k < 4; ++k) O[c][k] = f32x16{};
    float lrun[2] = {0.f, 0.f};
    const LAS unsigned char* Qb = lds + QOFFB + wid * 8192;
    ATT_DMA(t_lo, t_lo & 1);
    for (int t = t_lo; t <= t_hi; ++t) {
        asm volatile("s_waitcnt vmcnt(0)\n\ts_barrier" ::: "memory");
        if (t < t_hi) ATT_DMA(t + 1, (t + 1) & 1);
        int ln_ = lane; asm volatile("" : "+v"(ln_));
        const int r32 = ln_ & 31, hi = ln_ >> 5;
        const int rp = (r32 & ~12) | ((r32 & 4) << 1) | ((r32 & 8) >> 1);
        const int ksw = r32 & 15; const int kbase = r32 * 256; const int kswp = rp & 15; const int kbasep = rp * 256; const int vsw = (r32 >> 1) & 7; const int vbase = r32 * 128;
        const LAS unsigned char* Kb = lds + (t & 1) * KBUFB; const LAS unsigned char* Vb = lds + VOFFB + (t & 1) * KBUFB;
        const float dq = (float)(qpos - t * KVB - 8 * hi);
        float mfix[2]; { const LAS float* red2 = (const LAS float*)(lds + 131072); mfix[0] = red2[64 + wid * 32 + r32]; mfix[1] = red2[320 + wid * 32 + r32]; }
#pragma unroll
        for (int c = 0; c < 2; ++c) {
        bf16x8 qv4[4];
#pragma unroll
        for (int d0 = 0; d0 < 4; ++d0) qv4[d0] = *(const LAS bf16x8*)(Qb + kbase + (((c * 8 + d0 * 2 + hi) ^ ksw) * 16));
#pragma unroll
        for (int hf = 0; hf < 2; ++hf) {
            bf16x8 pk[2];
            {
            f32x16 p0 = f32x16{};
            {
                bf16x8 ka[4];
#pragma unroll
                for (int d0 = 0; d0 < 4; ++d0) ka[d0] = *(const LAS bf16x8*)(Kb + kbasep + (((c * 8 + d0 * 2 + hi) ^ kswp) * 16) + hf * 8192);
                asm volatile("" : "+v"(ka[0]), "+v"(ka[1]), "+v"(ka[2]), "+v"(ka[3]));
#pragma unroll
                for (int d0 = 0; d0 < 4; ++d0) p0 = __builtin_amdgcn_mfma_f32_32x32x16_bf16(ka[d0], qv4[d0], p0, 0, 0, 0);
            }
            float s = 0.f;
#pragma unroll
            for (int r = 0; r < 16; ++r) { const float cr = (float)((r & 7) + 16 * (r >> 3) + 32 * hf);
                p0[r] = __builtin_amdgcn_exp2f((p0[r] - slope2 * fabsf(dq - cr)) - mfix[c]); s += p0[r]; if ((r & 3) == 3) asm volatile("" : "+v"(s)); }
            lrun[c] += s;
#pragma unroll
            for (int k2 = 0; k2 < 2; ++k2) {
                typedef unsigned u32x4v __attribute__((ext_vector_type(4)));
                u32x4v w0;
                w0.x = cvtpk(p0[8 * k2 + 0], p0[8 * k2 + 1]); w0.y = cvtpk(p0[8 * k2 + 2], p0[8 * k2 + 3]); w0.z = cvtpk(p0[8 * k2 + 4], p0[8 * k2 + 5]); w0.w = cvtpk(p0[8 * k2 + 6], p0[8 * k2 + 7]);
                pk[k2] = __builtin_bit_cast(bf16x8, w0); }
            }
#pragma unroll
            for (int bp = 0; bp < 2; ++bp) {
                bf16x8 vq[4];
#pragma unroll
                for (int u = 0; u < 4; ++u) vq[u] = *(const LAS bf16x8*)(Vb + (2 * bp + (u >> 1)) * 4096 + vbase + (((2 * (2 * hf + (u & 1)) + hi) ^ vsw) * 16));
                asm volatile("" : "+v"(vq[0]), "+v"(vq[1]), "+v"(vq[2]), "+v"(vq[3]));
#pragma unroll
                for (int u = 0; u < 4; ++u) O[c][2 * bp + (u >> 1)] = __builtin_amdgcn_mfma_f32_32x32x16_bf16(vq[u], pk[u & 1], O[c][2 * bp + (u >> 1)], 0, 0, 0);
            }
        }
        }
    }
#undef ATT_DMA
    const float i1 = 1.0f / swapsum(lrun[0]), i2 = lam / swapsum(lrun[1]);
    float ssq = 0.f;
#pragma unroll
    for (int k = 0; k < 4; ++k)
#pragma unroll
        for (int r = 0; r < 16; ++r) { const float o = O[0][k][r] * i1 - O[1][k][r] * i2; O[0][k][r] = o; ssq += o * o; }
    ssq = swapsum(ssq);
    const float rn = __builtin_amdgcn_rsqf(ssq * (1.0f / 128.0f) + 1e-5f) * 0.8f * ABL_ATT;
    bf16_t* orow = MIX + (size_t)(b * SEQ + qpos) * 1024 + h * 128;
#pragma unroll
    for (int k = 0; k < 4; ++k)
#pragma unroll
        for (int g = 0; g < 4; ++g) { const int dv = 32 * k + 8 * g + 4 * hi; const f32x4 gs = *(const f32x4*)(gsub + dv);
            u32x2 w; w.x = cvtpk(O[0][k][4 * g] * rn * gs[0], O[0][k][4 * g + 1] * rn * gs[1]); w.y = cvtpk(O[0][k][4 * g + 2] * rn * gs[2], O[0][k][4 * g + 3] * rn * gs[3]);
            *(u32x2*)(orow + dv) = w; }
}
#undef LAS
}
#define GAS __attribute__((address_space(1)))
#define LAS __attribute__((address_space(3)))
typedef unsigned short bf16;
typedef unsigned v4u __attribute__((ext_vector_type(4)));
typedef float f32x4 __attribute__((ext_vector_type(4)));
constexpr int NWAVES = 8;
constexpr int BATCH = 8, SEQ = 4096, DM = 1024, MTOK = BATCH * SEQ, DFF = 2816, NUP = 2 * DFF;
constexpr size_t MiB = 1u << 20;
constexpr size_t WS_WQK = 2 * MiB, WS_WVAB = 4 * MiB, WS_WOUT = 8 * MiB, WS_WUP = 10 * MiB, WS_WDOWN = 22 * MiB, WS_SS1 = 28 * MiB, WS_SS2 = 30 * MiB, WS_HALO = 32 * MiB;
constexpr size_t WS_XN = 48 * MiB, WS_QK = 112 * MiB, WS_VT = 176 * MiB, WS_T = 208 * MiB, WS_DFT = 272 * MiB, WS_MIX = 336 * MiB, WS_XB2 = 400 * MiB, WS_G = 48 * MiB, WS_PBUF = 464 * MiB, WS_END = 496 * MiB;
constexpr int RING_BYTES = 131072, XCH_OFF = RING_BYTES, TAB_OFF = RING_BYTES + 4096, LDS_BYTES = 147456;

__device__ __forceinline__ unsigned f2bf(float f) { unsigned u = __builtin_bit_cast(unsigned, f); return (u + 0x7fffu + ((u >> 16) & 1u)) >> 16; }
__device__ __forceinline__ unsigned pk2(float lo, float hi) { return f2bf(lo) | (f2bf(hi) << 16); }
__device__ __forceinline__ float wave_sum(float v) { v = pg8::xsum<1>(v); v = pg8::xsum<2>(v); v = pg8::xsum<4>(v); v = pg8::xsum<8>(v); v = pg8::xsum<16>(v); v = pg8::xsum<32>(v); return v; }
__device__ __forceinline__ void tr_item(const float* W, int ldw, int k0, int sc0, const float* ks, float nscale, bf16* dst, int ldd, int n0, LAS float* scr, int lane) {
#pragma unroll
    for (int i = 0; i < 32; ++i) { const int kk = 2 * i + (lane >> 5); float v = W[(size_t)(k0 + kk) * ldw + sc0 + (lane & 31)] * nscale; if (ks) v *= ks[k0 + kk]; scr[kk * 33 + (lane & 31)] = v; }
    asm volatile("s_waitcnt lgkmcnt(0)" ::: "memory");
    const int c = lane & 7;
#pragma unroll
    for (int j = 0; j < 4; ++j) { const int n = (lane >> 3) + 8 * j; const LAS float* s = scr + (8 * c) * 33 + n;
        v4u o; o.x = pk2(s[0 * 33], s[1 * 33]); o.y = pk2(s[2 * 33], s[3 * 33]); o.z = pk2(s[4 * 33], s[5 * 33]); o.w = pk2(s[6 * 33], s[7 * 33]);
        *(v4u*)(dst + (size_t)(n0 + n) * ldd + k0 + 8 * c) = o; }
    asm volatile("s_waitcnt lgkmcnt(0)" ::: "memory");
}


#define XB_TMO      128
#define XB_XCNT(j)  (256  + 64 * (j))
#define XB_XSUB(j)  (1280 + 64 * (j))
#define XB_XGEN(j)  (2304 + 64 * (j))
#define XB_TOP      3328
#define XB_TOPGEN   3392
#define XCD_BAR_WORDS 3456
#define XB_SPIN_CAP (1u << 18)

__device__ __forceinline__ unsigned xb_ld(unsigned* p)              { return __hip_atomic_load(p, __ATOMIC_RELAXED, __HIP_MEMORY_SCOPE_AGENT); }
__device__ __forceinline__ unsigned xb_add(unsigned* p, unsigned v) { return __hip_atomic_fetch_add(p, v, __ATOMIC_RELAXED, __HIP_MEMORY_SCOPE_AGENT); }
__device__ __forceinline__ unsigned xb_xcc_id() { return (unsigned)__builtin_amdgcn_s_getreg((3 << 11) | 20) & 0xFu; }
#define XB_SPIN(cond, bar) do { unsigned _sp = 0; while (cond) { __builtin_amdgcn_s_sleep(1); \
    if ((++_sp & 255u) == 0u) { if (xb_ld(&(bar)[XB_TMO])) break; if (_sp > XB_SPIN_CAP) { atomicAdd(&(bar)[XB_TMO], 1u); break; } } } } while (0)

struct XcdBarrier {
    unsigned* bar; unsigned x;
    volatile LAS unsigned* st;
};

__device__ __forceinline__ XcdBarrier xcd_barrier_post(unsigned* bar, volatile LAS unsigned* st) {
    XcdBarrier b; b.bar = bar; b.x = xb_xcc_id(); b.st = st;
    if (threadIdx.x == 0) (void)xb_add(&bar[XB_XCNT(b.x)], 1u);
    return b;
}
__device__ __forceinline__ void xcd_barrier_complete(unsigned* bar, unsigned x, unsigned& nloc, unsigned& nx) {
    const unsigned G = gridDim.x * gridDim.y * gridDim.z;
    unsigned sum, cnt, mine, sp = 0u;
    for (;;) {
        sum = 0u; cnt = 0u; mine = 0u;
#pragma unroll
        for (unsigned j = 0; j < 16; ++j) { const unsigned c = xb_ld(&bar[XB_XCNT(j)]); sum += c; cnt += (c > 0u) ? 1u : 0u; mine = (j == x) ? c : mine; }
        if (sum == G) break;
        __builtin_amdgcn_s_sleep(1);
        if ((++sp & 255u) == 0u) { if (xb_ld(&bar[XB_TMO])) break; if (sp > XB_SPIN_CAP) { atomicAdd(&bar[XB_TMO], 1u); break; } }
    }
    nloc = mine > 0u ? mine : 1u; nx = cnt > 0u ? cnt : 1u;
}

__device__ __forceinline__ void xcd_barrier(const XcdBarrier& b) {
    asm volatile("s_waitcnt vmcnt(0)" ::: "memory");
    __syncthreads();
    if (threadIdx.x == 0) {
        unsigned* bar = b.bar;
        __builtin_amdgcn_s_waitcnt(0);
        unsigned nloc = b.st[0], nx = b.st[1];
        if (nloc == 0u) { xcd_barrier_complete(bar, b.x, nloc, nx); b.st[0] = nloc; b.st[1] = nx; }
        const unsigned old = xb_add(&bar[XB_XSUB(b.x)], 1u);
        const unsigned gen = old / nloc;
        if (old + 1u == (gen + 1u) * nloc) {
            __builtin_amdgcn_fence(__ATOMIC_RELEASE, "agent");
            asm volatile("s_waitcnt vmcnt(0)" ::: "memory");
            const unsigned og = xb_add(&bar[XB_TOP], 1u);
            const unsigned tg = og / nx;
            if (og + 1u == (tg + 1u) * nx) xb_add(&bar[XB_TOPGEN], 1u);
            else XB_SPIN(xb_ld(&bar[XB_TOPGEN]) == tg, bar);
            __builtin_amdgcn_fence(__ATOMIC_ACQUIRE, "agent");
            xb_add(&bar[XB_XGEN(b.x)], 1u);
            asm volatile("s_waitcnt vmcnt(0)" ::: "memory");
        } else {
            XB_SPIN(xb_ld(&bar[XB_XGEN(b.x)]) == gen, bar);
            __builtin_amdgcn_fence(__ATOMIC_ACQUIRE, "agent");
            asm volatile("s_waitcnt vmcnt(0)" ::: "memory");
        }
    }
    __syncthreads();
}


#ifndef PROBE
#define PROBE 0
#endif
#if PROBE
__device__ __forceinline__ float bf2f(bf16 v) { return __builtin_bit_cast(float, (unsigned)v << 16); }
__device__ __forceinline__ unsigned hash32(unsigned x) { x ^= x >> 16; x *= 0x7feb352dU; x ^= x >> 15; x *= 0x846ca68bU; x ^= x >> 16; return x; }
__device__ __forceinline__ float wdot_bf(const bf16* a, const bf16* b, int K, int lane) { float s = 0.f; for (int k = lane; k < K; k += 64) s += bf2f(a[k]) * bf2f(b[k]); return wave_sum(s); }
__device__ __forceinline__ float wave_max(float v) {
    v = fmaxf(v, __builtin_bit_cast(float, __builtin_amdgcn_ds_swizzle(__builtin_bit_cast(int, v), (1 << 10) | 0x1f)));
    v = fmaxf(v, __builtin_bit_cast(float, __builtin_amdgcn_ds_swizzle(__builtin_bit_cast(int, v), (2 << 10) | 0x1f)));
    v = fmaxf(v, __builtin_bit_cast(float, __builtin_amdgcn_ds_swizzle(__builtin_bit_cast(int, v), (4 << 10) | 0x1f)));
    v = fmaxf(v, __builtin_bit_cast(float, __builtin_amdgcn_ds_swizzle(__builtin_bit_cast(int, v), (8 << 10) | 0x1f)));
    v = fmaxf(v, __builtin_bit_cast(float, __builtin_amdgcn_ds_swizzle(__builtin_bit_cast(int, v), (16 << 10) | 0x1f)));
    float a = v, b = v; asm volatile("s_nop 1\n\tv_permlane32_swap_b32 %0, %1" : "+v"(a), "+v"(b)); return fmaxf(a, b);
}
__device__ __forceinline__ void acc_err(float* E, int i, float d2, float w2, int lane) { if (lane == 0) { atomicAdd(E + 2 * i, d2); atomicAdd(E + 2 * i + 1, w2); } }
#endif
struct Args { const float* in[16]; float* out; unsigned char* ws; };

__global__ void __launch_bounds__(NWAVES * 64, 2) fwd_mega(Args args) {
    extern __shared__ __attribute__((aligned(16))) unsigned char lds_raw[];
    cg::grid_group grid = cg::this_grid();
    LAS unsigned char* lds = (LAS unsigned char*)lds_raw;
#define FRESH() int tid = threadIdx.x; asm volatile("" : "+v"(tid)); const int lane = tid & 63, wave = __builtin_amdgcn_readfirstlane(tid >> 6); const int gw = bid * NWAVES + wave, NGW = G * NWAVES; const int gt = bid * (NWAVES * 64) + tid, NGT = G * NWAVES * 64; (void)lane; (void)gw; (void)NGW; (void)gt; (void)NGT
    const int G = gridDim.x, bid = blockIdx.x;
    volatile LAS unsigned* xb_st = (volatile LAS unsigned*)(lds + 139264);
    if (threadIdx.x == 0) { xb_st[0] = 0u; xb_st[1] = 0u; }
    __syncthreads();
    if (args.ws == nullptr) grid.sync();
    XcdBarrier xbar = xcd_barrier_post((unsigned*)(args.ws + 65536), xb_st);
    unsigned char* ws = args.ws;
#if PROBE
    if (blockIdx.x == 0 && threadIdx.x == 0) ((unsigned long long*)(ws + 8192))[0] = __builtin_amdgcn_s_memrealtime();
#endif
    const float* x = args.in[0]; const float* g_mix = args.in[1]; const float* w_in = args.in[2];
    const float* g_subln = args.in[7]; const float* w_ft = args.in[8]; const float* w_out = args.in[9]; const float* g_ffn = args.in[10];
    const float* w_up = args.in[11]; const float* w_conv = args.in[12]; const float* b_conv = args.in[13]; const float* w_down = args.in[14]; const float* g_final = args.in[15];
    float* out = args.out;
    bf16* WQK = (bf16*)(ws + WS_WQK); bf16* WVAB = (bf16*)(ws + WS_WVAB); bf16* WOUT = (bf16*)(ws + WS_WOUT); bf16* WUP = (bf16*)(ws + WS_WUP); bf16* WDOWN = (bf16*)(ws + WS_WDOWN);
    float* SS1 = (float*)(ws + WS_SS1); float* SS2 = (float*)(ws + WS_SS2); float* HALO = (float*)(ws + WS_HALO);
    bf16* XN = (bf16*)(ws + WS_XN); bf16* QKB = (bf16*)(ws + WS_QK); bf16* VT = (bf16*)(ws + WS_VT); bf16* TA = (bf16*)(ws + WS_T); bf16* TB = (bf16*)(ws + WS_T + 32 * MiB); bf16* DFT = (bf16*)(ws + WS_DFT); float* PBUF = (float*)(ws + WS_PBUF); unsigned* DFLAGS = (unsigned*)(ws + 16384); unsigned* PCNT = (unsigned*)(ws + 32768); unsigned* KSHARED = (unsigned*)(ws + 49152); unsigned* XBAR = (unsigned*)(ws + 65536);
    bf16* MIX = (bf16*)(ws + WS_MIX); bf16* XB2 = (bf16*)(ws + WS_XB2); bf16* GB = (bf16*)(ws + WS_G);

    for (int rep_ = 0; rep_ < REP_P0; ++rep_) {
        FRESH();
#if PROBE
        if (bid == 0 && tid < 128) ((float*)(ws + 4096))[tid] = 0.f;
#endif
        LAS float* tab = (LAS float*)(lds + TAB_OFF);
        if (tid < 128) { tab[tid] = __builtin_amdgcn_cosf((float)tid * (1.0f / 128.0f)); tab[128 + tid] = __builtin_amdgcn_sinf((float)tid * (1.0f / 128.0f)); }
        __syncthreads();
        LAS float* scr = (LAS float*)(lds + wave * 16384);
        constexpr int I_QK = 32 * 16, I_V = 16 * 16, I_UP = 176 * 16, I_DN = 32 * 44, I_O = 32 * 8;
        constexpr int NITEMS = I_QK + I_V + I_UP + I_DN + I_O;
        for (int rr_ = 0; rr_ < REP_P0A; ++rr_)
        for (int it = gw; it < NITEMS; it += NGW) {
            int r = it;
            if (r < I_QK) { const int nb = r % 32, kb = r / 32; tr_item(w_in, 2048, 64 * kb, 32 * nb, g_mix, nb < 16 ? 0.125f * 1.4426950408889634f : 1.0f, WQK, 1024, 32 * nb, scr, lane); continue; } r -= I_QK;
            if (r < I_V) { const int nb = r % 16, kb = r / 16; tr_item(w_in, 2048, 64 * kb, 1024 + 32 * nb, g_mix, 1.0f, WVAB, 1024, 32 * nb, scr, lane); continue; } r -= I_V;
            if (r < I_UP) { const int nb = r % 176, kb = r / 176; const int pn = nb >> 3, lb = nb & 7; const int sc = lb < 4 ? 128 * pn + 32 * lb : DFF + 128 * pn + 32 * (lb - 4);
                tr_item(w_up, NUP, 64 * kb, sc, g_ffn, 1.0f, WUP, 1024, 32 * nb, scr, lane); continue; } r -= I_UP;
            if (r < I_DN) { const int nb = r % 32, kb = r / 32; tr_item(w_down, 1024, 64 * kb, 32 * nb, nullptr, 1.0f, WDOWN, DFF, 32 * nb, scr, lane); continue; } r -= I_DN;
            { const int nb = r % 32, kb = r / 32; tr_item(w_out, 1024, 64 * kb, 32 * nb, nullptr, 1.0f, WOUT, 1024, 32 * nb, scr, lane); }
        }
        for (int e0 = gt; e0 < 1024 * 4 * 128; e0 += 4 * NGT) { const int c2 = e0 & 127, gi = (e0 >> 7) & 3; int kx[4]; const float* wr_[4]; float ac[4], as[4];
#pragma unroll
            for (int q = 0; q < 4; ++q) { const int e = e0 + q * NGT; kx[q] = (e < 1024 * 4 * 128 ? e : e0) >> 9; wr_[q] = w_in + (size_t)kx[q] * 2048 + 1536 + gi * 128; ac[q] = 0.f; as[q] = 0.f; }
#pragma unroll 4
            for (int c = 0; c < 128; ++c) { const int ix = (c * c2) & 127; const float tc = tab[ix], ts = tab[128 + ix];
#pragma unroll
                for (int q = 0; q < 4; ++q) { const float w = wr_[q][c]; ac[q] += w * tc; as[q] += w * ts; } }
#pragma unroll
            for (int q = 0; q < 4; ++q) if (e0 + q * NGT < 1024 * 4 * 128) { const float sc = g_mix[kx[q]] * 0.08838834764831845f;
                WVAB[(size_t)(512 + gi * 128 + c2) * 1024 + kx[q]] = (bf16)f2bf(ac[q] * sc); WVAB[(size_t)(1024 + gi * 128 + c2) * 1024 + kx[q]] = (bf16)f2bf(as[q] * sc); } }
        for (int e0 = gt; e0 < 512 * 1024; e0 += 4 * NGT) { const int n = e0 & 1023; int kc[4]; const float* wf[4]; const float* wo[4]; float a[4];
#pragma unroll
            for (int q = 0; q < 4; ++q) { const int e = e0 + q * NGT; kc[q] = (e < 512 * 1024 ? e : e0) >> 10; wf[q] = w_ft + (size_t)kc[q] * 128; wo[q] = w_out + (size_t)(512 + (kc[q] >> 7) * 128) * 1024 + n; a[q] = 0.f; }
#pragma unroll 4
            for (int d = 0; d < 128; ++d)
#pragma unroll
                for (int q = 0; q < 4; ++q) a[q] += wf[q][d] * wo[q][(size_t)d * 1024];
#pragma unroll
            for (int q = 0; q < 4; ++q) if (e0 + q * NGT < 512 * 1024) WOUT[(size_t)n * 1024 + 512 + kc[q]] = (bf16)f2bf(a[q]); }
#define P0_DFT_ITEM(e) do { const int r = e >> 9, k8 = (e & 511) * 8; const bool isS = r >= 2048; const int sp = r & 2047; unsigned w[4]; \
_Pragma("unroll") \
            for (int j = 0; j < 4; ++j) { float v[2]; \
_Pragma("unroll") \
                for (int q = 0; q < 2; ++q) { const float ph = (float)((sp * (k8 + 2 * j + q)) & 4095) * (1.0f / 4096.0f); v[q] = isS ? __builtin_amdgcn_sinf(ph) : __builtin_amdgcn_cosf(ph); } \
                w[j] = pk2(v[0], v[1]); } \
            *(v4u*)(DFT + (size_t)r * 4096 + k8) = (v4u){w[0], w[1], w[2], w[3]}; } while (0)
        int edft = gt;
        for (int m0 = gw * 4; m0 < MTOK; m0 += NGW * 4) {
            f32x4 v[4][4]; float s[4];
#pragma unroll
            for (int r = 0; r < 4; ++r) { const f32x4* xr = (const f32x4*)(x + (size_t)(m0 + r) * DM) + lane;
#pragma unroll
                for (int j = 0; j < 4; ++j) v[r][j] = xr[64 * j]; }
#pragma unroll
            for (int q4 = 0; q4 < 4; ++q4) { if (edft < 4096 * 512) { const int e = edft; P0_DFT_ITEM(e); } edft += NGT; }
#pragma unroll
            for (int r = 0; r < 4; ++r) { s[r] = 0.f;
#pragma unroll
                for (int j = 0; j < 4; ++j) s[r] += (v[r][j].x * v[r][j].x + v[r][j].y * v[r][j].y) + (v[r][j].z * v[r][j].z + v[r][j].w * v[r][j].w); }
#pragma unroll
            for (int r = 0; r < 4; ++r) { const float rstd = __builtin_amdgcn_rsqf(wave_sum(s[r]) * (1.0f / DM) + 1e-6f); unsigned long long* o8 = (unsigned long long*)(XN + (size_t)(m0 + r) * DM) + lane;
#pragma unroll
                for (int j = 0; j < 4; ++j) o8[64 * j] = (unsigned long long)pk2(v[r][j].x * rstd, v[r][j].y * rstd) | ((unsigned long long)pk2(v[r][j].z * rstd, v[r][j].w * rstd) << 32); } }
        for (; edft < 4096 * 512; edft += NGT) { const int e = edft; P0_DFT_ITEM(e); }
#undef P0_DFT_ITEM
    }
    xcd_barrier(xbar);
#if PROBE
    if (blockIdx.x == 0 && threadIdx.x == 0) ((unsigned long long*)(ws + 8192))[1] = __builtin_amdgcn_s_memrealtime();
#endif
#ifdef EXTRA_SYNCS
    for (int q_ = 0; q_ < EXTRA_SYNCS; ++q_) grid.sync();
#endif
    for (int rep_ = 0; rep_ < REP_P1; ++rep_) {
        { pg8::Gemm g{XN, WQK, MTOK, 1024, 1024}; pg8::StaticOrder S; S.init(MTOK, 1024, G, bid); pg8::EpiStore E{QKB, nullptr, nullptr, 1024, 1.0f, 0};
          pg8::gemm_phase<pg8::EpiStore, pg8::StaticOrder, true, true, false>(lds, g, S, E); }
        { pg8::Gemm g{WVAB, XN, 1536, MTOK, 1024}; pg8::StaticOrder S; S.init(1536, MTOK, G, bid); pg8::EpiStore E{VT, TA, TB, 0, 1.0f, 2};
          pg8::gemm_phase<pg8::EpiStore, pg8::StaticOrder, true, true, false>(lds, g, S, E); }
    }
    xcd_barrier(xbar);
#if PROBE
    if (blockIdx.x == 0 && threadIdx.x == 0) ((unsigned long long*)(ws + 8192))[2] = __builtin_amdgcn_s_memrealtime();
#endif
    {
        FRESH();
        const float* lq1 = args.in[3]; const float* lk1 = args.in[4]; const float* lq2 = args.in[5]; const float* lk2 = args.in[6];
        const float d1 = wave_sum(lq1[lane] * lk1[lane]), d2 = wave_sum(lq2[lane] * lk2[lane]);
        const float lam = __expf(d1) - __expf(d2) + 0.2f;
        if (G == 256) att::kmax_slice(lds, QKB, KSHARED, bid >> 3, bid & 7);
        for (int rep_ = 0; rep_ < REP_ATT; ++rep_)
        if (G == 256) {
            volatile LAS int* qslot = (volatile LAS int*)(lds + 139264 + 64);
            for (;;) {
                if (tid == 0) qslot[0] = (int)__hip_atomic_fetch_add(KSHARED + 100, 1u, __ATOMIC_RELAXED, __HIP_MEMORY_SCOPE_AGENT);
                asm volatile("s_waitcnt vmcnt(0) lgkmcnt(0)\n\ts_barrier" ::: "memory");
                const int uq = __builtin_amdgcn_readfirstlane(qslot[0]);
                asm volatile("s_waitcnt lgkmcnt(0)\n\ts_barrier" ::: "memory");
                if (uq >= 512) break;
                const int hh = 3 - (uq >> 7), jj = uq & 127, rk = jj & 15;
                const int qbq = (rk & 1) ? 8 + (rk >> 1) : 7 - (rk >> 1);
                att::attn_unit(lds, QKB, VT, MIX, g_subln, lam, jj >> 4, hh, qbq, KSHARED);
            }
        } else
        for (int uix = bid; uix < 512; uix += G) { const int bh = uix >> 4, qb = uix & 15; att::attn_unit(lds, QKB, VT, MIX, g_subln, lam, bh >> 2, bh & 3, qb, nullptr); }
        asm volatile("s_waitcnt vmcnt(0) lgkmcnt(0)\n\ts_barrier" ::: "memory");
        for (int n = gw; n < 4096; n += NGW) { const bf16* ar = TA + (size_t)n * 4096; float sacc = 0.f;
            for (int i = 0; i < 8; ++i) { const v4u w = *(const v4u*)(ar + (i * 64 + lane) * 8);
#pragma unroll
                for (int j = 0; j < 4; ++j) { const unsigned ww = j == 0 ? w.x : j == 1 ? w.y : j == 2 ? w.z : w.w; sacc += __builtin_bit_cast(float, ww << 16) - __builtin_bit_cast(float, ww & 0xffff0000u); } }
            sacc = wave_sum(sacc);
            if (lane == 0) MIX[(size_t)((n >> 9) * 4096 + 2048) * 1024 + 512 + (n & 511)] = (bf16)f2bf(sacc * (ABL_FT / 64.0f)); }
        { pg8::Gemm g{DFT, TA, 4096, 4096, 4096, TB, 8}; pg8::DftOrder S{G, bid}; pg8::EpiDft E{PBUF, DFLAGS, MIX, ABL_FT / 64.0f};
          pg8::gemm_phase<pg8::EpiDft, pg8::DftOrder, true, true, false>(lds, g, S, E); }
    }
    xcd_barrier(xbar);
#if PROBE
    if (blockIdx.x == 0 && threadIdx.x == 0) ((unsigned long long*)(ws + 8192))[3] = __builtin_amdgcn_s_memrealtime();
#endif

#if PROBE && PROBE < 50
    {
        FRESH(); float* E = (float*)(ws + 4096);
        for (int s = 0; s < 2; ++s) { const unsigned id = hash32((unsigned)(gw * 2 + s) + 12345u); const int tok = id & 32767, col = (id >> 15) & 1023;
            const float want = wdot_bf(XN + (size_t)tok * 1024, WQK + (size_t)col * 1024, 1024, lane), got = bf2f(QKB[(size_t)tok * 1024 + col]); acc_err(E, 0, (got - want) * (got - want), want * want, lane);  acc_err(E, 6, got * want, want * want, lane);
            float wh; { float s_ = 0.f; for (int k = lane; k < 1024; k += 64) if (((k >> 6) & 1) == 0) s_ += bf2f(XN[(size_t)tok * 1024 + k]) * bf2f(WQK[(size_t)col * 1024 + k]); wh = wave_sum(s_); } acc_err(E, 7, (got - wh) * (got - wh), wh * wh, lane);
            const float wh2 = want - wh; acc_err(E, 8, (got - wh2) * (got - wh2), wh2 * wh2, lane);
            { const float bad = fabsf(got - want) > 0.1f * fabsf(want) + 0.02f ? 1.f : 0.f; const int hb[6] = {(tok >> 6) & 1, (tok >> 7) & 1, (col >> 7) & 1, (tok >> 4) & 1, (col >> 5) & 1, (tok >> 8) & 1};
              for (int h = 0; h < 6; ++h) acc_err(E, 10 + 2 * h + (hb[h] ? 0 : 1), bad, 1.f, lane); } }
        for (int s = 0; s < 2; ++s) { const unsigned id = hash32((unsigned)(gw * 2 + s) + 4711u); const int tok = id & 32767, col = (id >> 15) & 1023;
            const int k = lane * 16 + (id >> 25) % 16; const float wsrc = w_in[(size_t)k * 2048 + col] * g_mix[k] * (col < 512 ? 0.125f * 1.4426950408889634f : 1.0f), wgot = bf2f(WQK[(size_t)col * 1024 + k]);
            float ssq = 0.f; for (int kk = lane; kk < 1024; kk += 64) { const float xv = x[(size_t)tok * 1024 + kk]; ssq += xv * xv; } const float rstd = rsqrtf(wave_sum(ssq) * (1.0f / 1024.0f) + 1e-6f);
            const float xsrc = x[(size_t)tok * 1024 + k] * rstd, xgot = bf2f(XN[(size_t)tok * 1024 + k]);
            acc_err(E, 9, wave_sum((wgot - wsrc) * (wgot - wsrc)), wave_sum(wsrc * wsrc), lane); acc_err(E, 22, wave_sum((xgot - xsrc) * (xgot - xsrc)), wave_sum(xsrc * xsrc), lane); }
        for (int s = 0; s < 2; ++s) { const unsigned id = hash32((unsigned)(gw * 2 + s) + 777u); const int tok = id & 32767, n = (id >> 15) % 1536; const int b = tok >> 12, sq = tok & 4095;
            const float want = wdot_bf(WVAB + (size_t)n * 1024, XN + (size_t)tok * 1024, 1024, lane);
            const float got = n < 512 ? bf2f(VT[(size_t)(b * 512 + n) * 4096 + sq]) : n < 1024 ? bf2f(TB[(size_t)(b * 512 + n - 512) * 8192 + sq]) : bf2f(TB[(size_t)(b * 512 + n - 1024) * 8192 + 4096 + sq]);
            acc_err(E, 1, (got - want) * (got - want), want * want, lane); }
        { const unsigned id = hash32((unsigned)gw + 999u); const int b = id & 7, sp = (id >> 3) & 4095, c2 = (id >> 15) & 511;
            const float want = wdot_bf(DFT + (size_t)sp * 8192, TB + (size_t)(b * 512 + c2) * 8192, 8192, lane) * (1.0f / 64.0f), got = bf2f(MIX[(size_t)(b * 4096 + sp) * 1024 + 512 + c2]);
            acc_err(E, 3, (got - want) * (got - want), want * want, lane); }
        {
            const unsigned id = hash32((unsigned)gw + 4242u); const int b = id & 7, h = (id >> 3) & 3, q = (id >> 5) & 4095;
            const float* lq1 = args.in[3]; const float* lk1 = args.in[4]; const float* lq2 = args.in[5]; const float* lk2 = args.in[6];
            const float lam = __expf(wave_sum(lq1[lane] * lk1[lane])) - __expf(wave_sum(lq2[lane] * lk2[lane])) + 0.2f;
            const float slope2 = exp2f(-2.0f * (float)(h + 1)) * 1.4426950408889634f;
            const bf16* Qp = QKB + (size_t)(b * 4096 + q) * 1024 + h * 128; LAS float* av = (LAS float*)(lds + wave * 16384);
            float m0 = -1e30f, m1 = -1e30f, l0 = 0.f, l1 = 0.f;
            for (int kv = lane; kv < 4096; kv += 64) { const bf16* Kp = QKB + (size_t)(b * 4096 + kv) * 1024 + 512 + h * 128; float s0 = 0.f, s1 = 0.f;
                for (int d = 0; d < 64; ++d) { s0 += bf2f(Qp[d]) * bf2f(Kp[d]); s1 += bf2f(Qp[64 + d]) * bf2f(Kp[64 + d]); }
                const float bias = slope2 * fabsf((float)(q - kv)); s0 -= bias; s1 -= bias;
                { const float mn = fmaxf(m0, s0); l0 = l0 * exp2f(m0 - mn) + exp2f(s0 - mn); m0 = mn; } { const float mn = fmaxf(m1, s1); l1 = l1 * exp2f(m1 - mn) + exp2f(s1 - mn); m1 = mn; } }
            const float M0 = wave_max(m0), M1 = wave_max(m1); const float L0 = wave_sum(l0 * exp2f(m0 - M0)), L1 = wave_sum(l1 * exp2f(m1 - M1));
            for (int kv = lane; kv < 4096; kv += 64) { const bf16* Kp = QKB + (size_t)(b * 4096 + kv) * 1024 + 512 + h * 128; float s0 = 0.f, s1 = 0.f;
                for (int d = 0; d < 64; ++d) { s0 += bf2f(Qp[d]) * bf2f(Kp[d]); s1 += bf2f(Qp[64 + d]) * bf2f(Kp[64 + d]); }
                const float bias = slope2 * fabsf((float)(q - kv)); s0 -= bias; s1 -= bias;
                av[kv] = exp2f(s0 - M0) / L0 - lam * exp2f(s1 - M1) / L1; }
            asm volatile("s_waitcnt lgkmcnt(0)" ::: "memory");
            float o[2];
            for (int i = 0; i < 2; ++i) { const bf16* Vp = VT + (size_t)(b * 512 + h * 128 + lane + 64 * i) * 4096; float a = 0.f; for (int kv = 0; kv < 4096; ++kv) a += av[kv] * bf2f(Vp[kv]); o[i] = a; }
            const float rn = rsqrtf(wave_sum(o[0] * o[0] + o[1] * o[1]) * (1.0f / 128.0f) + 1e-5f) * 0.8f; float d2 = 0.f, w2 = 0.f;
            for (int i = 0; i < 2; ++i) { const float want = o[i] * rn * g_subln[lane + 64 * i], got = bf2f(MIX[(size_t)(b * 4096 + q) * 1024 + h * 128 + lane + 64 * i]); d2 += (got - want) * (got - want); w2 += want * want; }
            acc_err(E, 2, wave_sum(d2), wave_sum(w2), lane);
            asm volatile("s_waitcnt lgkmcnt(0)\n\ts_barrier" ::: "memory");
        }
    }
#endif
#ifdef EXTRA_XB
    _Pragma("unroll 1") for (int q_ = 0; q_ < EXTRA_XB; ++q_) { asm volatile("" ::: "memory"); xcd_barrier(xbar); }
#endif
    for (int rep_ = 0; rep_ < REP_P3; ++rep_)
    { pg8::Gemm g{MIX, WOUT, MTOK, 1024, 1024}; pg8::StaticOrder S; S.init(MTOK, 1024, G, bid); pg8::EpiRes E{x, nullptr, nullptr, XB2, SS1, 1.0f};
      pg8::gemm_phase<pg8::EpiRes, pg8::StaticOrder, true, true, false>(lds, g, S, E); }
    xcd_barrier(xbar);
#if PROBE
    if (blockIdx.x == 0 && threadIdx.x == 0) ((unsigned long long*)(ws + 8192))[4] = __builtin_amdgcn_s_memrealtime();
#endif

#if PROBE && PROBE < 50
    {
        FRESH(); float* E = (float*)(ws + 4096);
        for (int s = 0; s < 2; ++s) { const unsigned id = hash32((unsigned)(gw * 2 + s) + 31337u); const int tok = id & 32767, n = (id >> 15) & 1023;
            const float want = x[(size_t)tok * 1024 + n] + wdot_bf(MIX + (size_t)tok * 1024, WOUT + (size_t)n * 1024, 1024, lane), got = out[(size_t)tok * 1024 + n]; acc_err(E, 4, (got - want) * (got - want), want * want, lane); }
    }
#endif
    for (int rep_ = 0; rep_ < REP_P4; ++rep_)
    { pg8::Gemm g{XB2, WUP, MTOK, NUP, 1024}; pg8::StaticOrder S; S.init(MTOK, NUP, G, bid); pg8::EpiConv E{SS1, w_conv, b_conv, GB, HALO, (LAS float*)(lds + XCH_OFF)};
      pg8::gemm_phase<pg8::EpiConv, pg8::StaticOrder, true, true, true>(lds, g, S, E); }
    xcd_barrier(xbar);
#if PROBE
    if (blockIdx.x == 0 && threadIdx.x == 0) ((unsigned long long*)(ws + 8192))[5] = __builtin_amdgcn_s_memrealtime();
#endif
    { FRESH();
    for (int e = gt; e < 128 * 2 * (DFF / 4); e += NGT) { const int j4 = (e % (DFF / 4)) * 4, pw = e / (DFF / 4), pm = pw >> 1, which = pw & 1; const int pn = j4 >> 7, lc = j4 & 127;
        const float* h0 = HALO + (size_t)pm * 4 * NUP + pn * 256 + lc; f32x4 cv[2];
#pragma unroll
        for (int bj = 0; bj < 2; ++bj) { const float* hb = h0 + bj * 128; f32x4 up, cu, dn; const f32x4 z = (f32x4){0.f, 0.f, 0.f, 0.f};
            if (which == 0) { up = (pm & 15) ? *(const f32x4*)(hb - (size_t)4 * NUP + (size_t)3 * NUP) : z; cu = *(const f32x4*)(hb); dn = *(const f32x4*)(hb + NUP); }
            else { up = *(const f32x4*)(hb + (size_t)2 * NUP); cu = *(const f32x4*)(hb + (size_t)3 * NUP); dn = ((pm & 15) != 15) ? *(const f32x4*)(hb + (size_t)4 * NUP) : z; }
            const int jc = j4 + bj * DFF; cv[bj] = *(const f32x4*)(w_conv + jc) * up + *(const f32x4*)(w_conv + NUP + jc) * cu + *(const f32x4*)(w_conv + 2 * NUP + jc) * dn + *(const f32x4*)(b_conv + jc); }
        float r[4];
#pragma unroll
        for (int q = 0; q < 4; ++q) { const float gg = cv[0][q]; r[q] = gg * __builtin_amdgcn_rcpf(1.0f + __builtin_amdgcn_exp2f(-1.4426950408889634f * gg)) * cv[1][q]; }
        *(unsigned long long*)(GB + (size_t)(pm * 256 + (which ? 255 : 0)) * DFF + j4) = (unsigned long long)pk2(r[0], r[1]) | ((unsigned long long)pk2(r[2], r[3]) << 32); } }
    xcd_barrier(xbar);
#if PROBE
    if (blockIdx.x == 0 && threadIdx.x == 0) ((unsigned long long*)(ws + 8192))[6] = __builtin_amdgcn_s_memrealtime();
#endif

#if PROBE && PROBE < 50
    {
        FRESH(); float* E = (float*)(ws + 4096);
        for (int s = 0; s < 2; ++s) { const unsigned id = hash32((unsigned)(gw * 2 + s) + 55555u); int tok = id & 32767; const int j = (id >> 15) % DFF; const int md = (id >> 28) & 7;
            if (md == 1) tok = (tok & ~255) + 7; if (md == 2) tok = (tok & ~255) + 8; if (md == 3) tok = (tok & ~255) + 63; if (md == 4) tok = (tok & ~255) + 3; if (md == 5) tok = (tok & ~255) + 64;
            const int rowg = (j >> 7) * 256 + (j & 127); float cg = b_conv[j], cv = b_conv[DFF + j];
            for (int d = -1; d <= 1; ++d) { const int r = tok + d; if ((r >> 12) != (tok >> 12) || r < 0) continue;
                float ssum = 0.f; for (int i = 0; i < 16; ++i) ssum += SS1[(size_t)r * 16 + i]; const float rstd = rsqrtf(ssum * (1.0f / 1024.0f) + 1e-6f);
                const float ug = rstd * wdot_bf(XB2 + (size_t)r * 1024, WUP + (size_t)rowg * 1024, 1024, lane), uv = rstd * wdot_bf(XB2 + (size_t)r * 1024, WUP + (size_t)(rowg + 128) * 1024, 1024, lane);
                cg += w_conv[(size_t)(d + 1) * NUP + j] * ug; cv += w_conv[(size_t)(d + 1) * NUP + DFF + j] * uv; }
            const float want = cg / (1.0f + __expf(-cg)) * cv, got = bf2f(GB[(size_t)tok * DFF + j]); acc_err(E, 5, (got - want) * (got - want), want * want, lane); acc_err(E, 40 + (md > 5 ? 0 : md), (got - want) * (got - want), want * want, lane); }
    }
    xcd_barrier(xbar);
#endif
    for (int rep5_ = 0; rep5_ < REP_P5; ++rep5_)
    if (G == 256 && !FORCE_UNFUSED) {
      pg8::Gemm g{GB, WDOWN, MTOK, 1024, DFF}; pg8::StaticOrder S; S.init(MTOK, 1024, G, bid); pg8::EpiResNorm E{XB2, out, SS2, PCNT, g_final, ABL_FFN, 1u};
      pg8::gemm_phase<pg8::EpiResNorm, pg8::StaticOrder, P5_ALIGN, P5_SP2, false>(lds, g, S, E);
    } else {
    { pg8::Gemm g{GB, WDOWN, MTOK, 1024, DFF}; pg8::StaticOrder S; S.init(MTOK, 1024, G, bid); pg8::EpiRes E{nullptr, XB2, out, nullptr, SS2, ABL_FFN};
      pg8::gemm_phase<pg8::EpiRes, pg8::StaticOrder, true, true, false>(lds, g, S, E); }
    xcd_barrier(xbar);
    { FRESH();
    for (int m = gw; m < MTOK; m += NGW) { f32x4* xr = (f32x4*)(out + (size_t)m * DM) + lane; const float sp = lane < 16 ? SS2[(size_t)m * 16 + lane] : 0.f;
        const float rstd = __builtin_amdgcn_rsqf(wave_sum(sp) * (1.0f / DM) + 1e-6f);
#pragma unroll
        for (int j = 0; j < 4; ++j) { const f32x4 gf = ((const f32x4*)g_final)[lane + 64 * j]; const f32x4 v = xr[64 * j]; xr[64 * j] = v * rstd * gf; } } }
    }

#if PROBE
    xcd_barrier(xbar);
    { FRESH(); const float* E = (const float*)(ws + 4096); float code;
      if (PROBE == 2) { int mask = 0; for (int h = 0; h < 6; ++h) { const float f1 = E[2 * (10 + 2 * h)] / E[2 * (10 + 2 * h) + 1], f0 = E[2 * (11 + 2 * h)] / E[2 * (11 + 2 * h) + 1]; if (f1 > 0.8f && f0 < 0.2f) mask |= 1 << h; } code = (float)mask; }
      else if (PROBE == 3) { int mask = 0; for (int h = 0; h < 6; ++h) { const float f1 = E[2 * (10 + 2 * h)] / E[2 * (10 + 2 * h) + 1], f0 = E[2 * (11 + 2 * h)] / E[2 * (11 + 2 * h) + 1]; if (f0 > 0.8f && f1 < 0.2f) mask |= 1 << h; } code = (float)mask; }
      else if (PROBE == 4) { int mask = 0; const float fl = (float)lane;
          if (pg8::xsum<1>(fl) != (float)(lane + (lane ^ 1))) mask |= 1; if (pg8::xsum<2>(fl) != (float)(lane + (lane ^ 2))) mask |= 2; if (pg8::xsum<4>(fl) != (float)(lane + (lane ^ 4))) mask |= 4;
          if (pg8::xsum<8>(fl) != (float)(lane + (lane ^ 8))) mask |= 8; if (pg8::xsum<16>(fl) != (float)(lane + (lane ^ 16))) mask |= 16; if (pg8::xsum<32>(fl) != (float)(lane + (lane ^ 32))) mask |= 32;
          mask = __any(mask & 1) * 1 + __any(mask & 2) * 2 + __any(mask & 4) * 4 + __any(mask & 8) * 8 + __any(mask & 16) * 16 + __any(mask & 32) * 32; code = (float)mask; }
      else if (PROBE == 5) { int mask = 0; for (int i = 0; i < 6; ++i) if (!(E[2 * (40 + i)] <= 3e-3f * E[2 * (40 + i) + 1])) mask |= 1 << i; code = (float)mask; }
      else if (PROBE == 6) { int mask = 0; const int fr = lane & 15;
          const int a = __builtin_amdgcn_update_dpp(0, lane + 100, 0x111, 0xf, 0xf, true), b = __builtin_amdgcn_update_dpp(0, lane + 100, 0x101, 0xf, 0xf, true);
          if (a != (fr == 0 ? 0 : lane + 99)) mask |= 1; if (b != (fr == 15 ? 0 : lane + 101)) mask |= 2; if (a == (fr == 15 ? 0 : lane + 101)) mask |= 4; if (b == (fr == 0 ? 0 : lane + 99)) mask |= 8;
          mask = __any(mask & 1) * 1 + __any(mask & 2) * 2 + __all(mask & 4) * 4 + __all(mask & 8) * 8; code = (float)mask; }
      else if (PROBE >= 50 && PROBE < 60) { const unsigned long long* ts = (const unsigned long long*)(ws + 8192); code = (float)(ts[PROBE - 50 + 1] - ts[PROBE - 50]) * 0.01f; }
      else if (PROBE == 1) { int mask = 0; for (int i = 0; i < 6; ++i) if (!(E[2 * i] <= 3e-3f * E[2 * i + 1])) mask |= 1 << i; code = (float)mask; }
      else { const int i = PROBE - 10; code = 1e6f * E[2 * i] / E[2 * i + 1]; }
      const float kk = sqrtf(code);
      for (int e = gt; e < MTOK * DM / 4; e += NGT) ((f32x4*)out)[e] = (f32x4){kk, kk, kk, kk}; }
#endif
}

extern "C" void kernel_launch(void* const* d_in, const int* in_sizes, int n_in, void* d_out, int out_size, void* d_ws, size_t ws_size, hipStream_t stream) {
    static int grid = 0;
    if (grid == 0) {
        if (n_in != 16 || out_size != MTOK * DM || ws_size < WS_END) { fprintf(stderr, "kernel_launch: unexpected shapes (n_in %d out %d ws %zu)\n", n_in, out_size, ws_size); grid = -1; return; }
        int dev = 0, cus = 0, per_cu = 0;
        hipGetDevice(&dev); hipDeviceGetAttribute(&cus, hipDeviceAttributeMultiprocessorCount, dev);
        hipFuncSetAttribute((const void*)fwd_mega, hipFuncAttributeMaxDynamicSharedMemorySize, LDS_BYTES);
        hipOccupancyMaxActiveBlocksPerMultiprocessor(&per_cu, (const void*)fwd_mega, NWAVES * 64, LDS_BYTES);
        if (per_cu < 1) { fprintf(stderr, "kernel_launch: occupancy query says %d blocks per CU\n", per_cu); per_cu = 1; }
        (void)hipGetLastError();
        grid = cus;
    }
    if (grid < 0) return;
    if (hipMemsetAsync(d_ws, 0, 131072, stream) != hipSuccess) { fprintf(stderr, "kernel_launch: hipMemsetAsync of the control words failed\n"); return; }
    Args a{};
    for (int i = 0; i < 16; ++i) a.in[i] = (const float*)d_in[i];
    a.out = (float*)d_out; a.ws = (unsigned char*)d_ws;
    void* kargs[] = {&a};
    hipError_t e = hipLaunchCooperativeKernel((const void*)fwd_mega, dim3(grid), dim3(NWAVES * 64), kargs, LDS_BYTES, stream);
    if (e != hipSuccess) fprintf(stderr, "cooperative launch failed: %s (grid %d)\n", hipGetErrorString(e), grid);
}
```

```cpp
#include <hip/hip_runtime.h>
#include <hip/hip_cooperative_groups.h>
#include <cstdio>
#include <cstdint>
namespace cg = cooperative_groups;
#ifndef ABL_FFN
#define ABL_FFN 1.0f
#endif
#ifndef ABL_ATT
#define ABL_ATT 1.0f
#endif
#ifndef ABL_FT
#define ABL_FT 1.0f
#endif
#ifndef REP_P0
#define REP_P0 1
#endif
#ifndef REP_P1
#define REP_P1 1
#endif
#ifndef REP_ATT
#define REP_ATT 1
#endif
#ifndef REP_DFT
#define REP_DFT 1
#endif
#ifndef REP_P3
#define REP_P3 1
#endif
#ifndef REP_P4
#define REP_P4 1
#endif
#ifndef REP_P0A
#define REP_P0A 1
#endif
#ifndef REP_P0B
#define REP_P0B 1
#endif
#ifndef REP_P0C
#define REP_P0C 1
#endif
#ifndef REP_P0F
#define REP_P0F 1
#endif
#ifndef REP_P5
#define REP_P5 1
#endif
#ifndef FORCE_UNFUSED
#define FORCE_UNFUSED 0
#endif
#ifndef P5_SP2
#define P5_SP2 true
#endif
#ifndef P5_ALIGN
#define P5_ALIGN true
#endif
namespace pg8 {
#define PG8_LAS __attribute__((address_space(3)))
typedef unsigned short bf16_t;
typedef short bf16x8 __attribute__((ext_vector_type(8)));
typedef float f32x4 __attribute__((ext_vector_type(4)));
typedef unsigned u32x4 __attribute__((ext_vector_type(4)));
constexpr int BM = 256, BK = 64, HALF = 128, HTB = HALF * BK * 2  , STAGE_BYTES = 8 * HTB, NXCD = 8, WGM = 8;

__host__ __device__ __forceinline__ int lds_byte(int r, int c) { const int st = (r >> 4) * 2 + (c >> 5), rr = r & 15, cc = c & 31, ob = rr * 64 + cc * 2; return st * 1024 + (ob ^ (((ob >> 9) & 1) << 5)); }
__host__ __device__ __forceinline__ void stage_rc(int b, int& R, int& C) { const int st = b / 1024, sb = b % 1024, swz = sb ^ (((sb >> 9) & 1) << 5); R = (st >> 1) * 16 + swz / 64; C = (st & 1) * 32 + (swz % 64) / 2; }
__host__ __device__ __forceinline__ int perm32(int rho) { const int n = rho >> 4, i = rho & 15; return 8 * (i >> 2) + 4 * n + (i & 3); }

struct Unit { int pm, pn; };
struct Gemm { const bf16_t* A; const bf16_t* Bt; int M, N, K; const bf16_t* Bt2 = nullptr; int pm_split = 1 << 30; };

struct StaticOrder {
    int nM, nN, nwg, G, c;
    __host__ __device__ void init(int M, int N, int G_, int c_) { nM = M / BM; nN = N / BM; nwg = nM * nN; G = G_; c = c_; }
    __host__ __device__ bool next(int i, Unit& u) const {
        const long L = (long)i * G + c; if (L >= nwg) return false;
        int wgid = (int)L; { const int q = nwg / NXCD, r = nwg % NXCD, xcd = wgid % NXCD, off = wgid / NXCD; wgid = (xcd < r ? xcd * (q + 1) : r * (q + 1) + (xcd - r) * q) + off; }
        const int nig = WGM * nN, gid = wgid / nig, fm = gid * WGM, gsz = (nM - fm) < WGM ? (nM - fm) : WGM;
        u.pm = fm + ((wgid % nig) % gsz); u.pn = (wgid % nig) / gsz; return true;
    }
    __device__ __forceinline__ void a_ready(const Unit&) const {}
    __device__ __forceinline__ void done(const Unit&) const {}
};

__device__ __forceinline__ unsigned cvt_pk_bf16(float lo, float hi) { unsigned r; asm volatile("v_cvt_pk_bf16_f32 %0, %1, %2" : "=v"(r) : "v"(lo), "v"(hi)); return r; }

template <int K> __device__ __forceinline__ float xsum(float v) {
    if constexpr (K == 32) { float a = v, b = v;
        asm volatile("s_nop 1\n\tv_permlane32_swap_b32 %0, %1" : "+v"(a), "+v"(b)); return a + b; }
    else return v + __builtin_bit_cast(float, __builtin_amdgcn_ds_swizzle(__builtin_bit_cast(int, v), (K << 10) | 0x1f));
}
typedef float f32x2 __attribute__((ext_vector_type(2)));
struct EpiStore {
    static constexpr bool PERM = true, AFTER_DRAIN = false;
    bf16_t* O; bf16_t* O2; bf16_t* O3; int ldc; float scale; int mode;
    __device__ __forceinline__ void operator()(f32x4 (&acc)[2][2][4][2], const Unit& u, int wr, int wc, int fr, int fq) const {
        bf16_t* base = O; int ld = ldc; int row0, col0;
        if (mode == 0) { row0 = u.pm * BM; col0 = u.pn * BM; }
        else if (mode == 1) { row0 = (u.pn >> 1) * 4096 + u.pm * BM; col0 = 512 + (u.pn & 1) * BM; }
        else { const int sec = u.pm >> 1, b = u.pn >> 4, s0 = (u.pn & 15) * BM; row0 = b * 512 + (u.pm & 1) * BM;
               base = sec == 0 ? O : sec == 1 ? O2 : O3; ld = 4096; col0 = s0; }
        row0 += wr * 64 + fr; col0 += wc * 32 + 8 * fq;
        const float sc = scale;
#pragma unroll
        for (int ai = 0; ai < 2; ++ai)
#pragma unroll
            for (int m = 0; m < 4; ++m) { bf16_t* rowp = base + (size_t)(row0 + ai * HALF + m * 16) * ld + col0;
#pragma unroll
                for (int bj = 0; bj < 2; ++bj) { const f32x4 v0 = acc[ai][bj][m][0] * sc, v1 = acc[ai][bj][m][1] * sc;
                    u32x4 w; w.x = cvt_pk_bf16(v0[0], v0[1]); w.y = cvt_pk_bf16(v0[2], v0[3]); w.z = cvt_pk_bf16(v1[0], v1[1]); w.w = cvt_pk_bf16(v1[2], v1[3]);
                    *(u32x4*)(rowp + bj * HALF) = w; } }
    }
};

struct DftOrder {
    int G, c;
    __device__ __forceinline__ bool next(int i, Unit& u) const { const int L = i * G + c; if (L >= 256) return false; if (L < 128) { u.pm = L >> 4; u.pn = L & 15; } else { u.pm = 8 + ((L - 128) >> 4); u.pn = L & 15; } return true; }
    __device__ __forceinline__ void a_ready(const Unit&) const {}
    __device__ __forceinline__ void done(const Unit&) const {}
};
struct EpiDft {
    static constexpr bool PERM = true, AFTER_DRAIN = false;
    float* Pbuf; unsigned* flags; bf16_t* MIX; float scale; const bf16_t* TAu;
    __device__ __forceinline__ void operator()(f32x4 (&acc)[2][2][4][2], const Unit& u, int wr, int wc, int fr, int fq) const {
        const int colt = wc * 32 + 8 * fq;
        if (u.pm < 8) {
            float* pb = Pbuf + (size_t)(u.pm * BM + wr * 64 + fr) * 4096 + u.pn * BM + colt;
            { const float sg = (fr & 1) ? -1.0f : 1.0f;
#pragma unroll
              for (int bj = 0; bj < 2; ++bj)
#pragma unroll
                  for (int n = 0; n < 2; ++n) { f32x4 ny;
#pragma unroll
                      for (int e = 0; e < 4; ++e) ny[e] = sg * __builtin_bit_cast(float, (unsigned)TAu[(size_t)(u.pn * BM + bj * HALF + colt + 4 * n + e) * 4096 + 2048] << 16);
#pragma unroll
                      for (int ai = 0; ai < 2; ++ai)
#pragma unroll
                          for (int mm = 0; mm < 4; ++mm) acc[ai][bj][mm][n] = acc[ai][bj][mm][n] + ny; } }
#pragma unroll
            for (int ai = 0; ai < 2; ++ai)
#pragma unroll
                for (int m = 0; m < 4; ++m)
#pragma unroll
                    for (int bj = 0; bj < 2; ++bj) { float* q = pb + (size_t)(ai * HALF + m * 16) * 4096 + bj * HALF; *(f32x4*)q = acc[ai][bj][m][0]; *(f32x4*)(q + 4) = acc[ai][bj][m][1]; }
            asm volatile("s_waitcnt vmcnt(0)\n\ts_barrier" ::: "memory");
            if (threadIdx.x == 0) { __builtin_amdgcn_fence(__ATOMIC_RELEASE, "agent"); asm volatile("s_waitcnt vmcnt(0)" ::: "memory");
                __hip_atomic_store(flags + u.pm * 16 + u.pn, 1u, __ATOMIC_RELAXED, __HIP_MEMORY_SCOPE_AGENT); }
        } else {
            const int pmq = u.pm - 8; unsigned* fl = flags + pmq * 16 + u.pn;
            for (unsigned sp = 0; sp < (1u << 22); ++sp) { if (__hip_atomic_load(fl, __ATOMIC_RELAXED, __HIP_MEMORY_SCOPE_AGENT) != 0u) break; __builtin_amdgcn_s_sleep(4); }
            __builtin_amdgcn_fence(__ATOMIC_ACQUIRE, "agent"); asm volatile("s_waitcnt vmcnt(0)" ::: "memory");
            asm volatile("s_barrier" ::: "memory");
            const int b = u.pn >> 1, c0 = 512 + (u.pn & 1) * BM + colt; const int s0 = pmq * BM + wr * 64 + fr;
            const float* pb = Pbuf + (size_t)s0 * 4096 + u.pn * BM + colt; const float sc = scale;
#pragma unroll
            for (int ai = 0; ai < 2; ++ai)
#pragma unroll
                for (int m = 0; m < 4; ++m) { const int s = s0 + ai * HALF + m * 16; bf16_t* r0 = MIX + (size_t)(b * 4096 + s) * 1024 + c0; bf16_t* r1 = MIX + (size_t)(b * 4096 + (s ? 4096 - s : 0)) * 1024 + c0;
#pragma unroll
                    for (int bj = 0; bj < 2; ++bj) { const float* q = pb + (size_t)(ai * HALF + m * 16) * 4096 + bj * HALF; const f32x4 p0 = *(const f32x4*)q, p1 = *(const f32x4*)(q + 4);
                        const f32x4 a0 = (p0 - acc[ai][bj][m][0]) * sc, a1 = (p1 - acc[ai][bj][m][1]) * sc, b0 = (p0 + acc[ai][bj][m][0]) * sc, b1 = (p1 + acc[ai][bj][m][1]) * sc;
                        u32x4 w; w.x = cvt_pk_bf16(a0[0], a0[1]); w.y = cvt_pk_bf16(a0[2], a0[3]); w.z = cvt_pk_bf16(a1[0], a1[1]); w.w = cvt_pk_bf16(a1[2], a1[3]); *(u32x4*)(r0 + bj * HALF) = w;
                        if (s) { u32x4 v; v.x = cvt_pk_bf16(b0[0], b0[1]); v.y = cvt_pk_bf16(b0[2], b0[3]); v.z = cvt_pk_bf16(b1[0], b1[1]); v.w = cvt_pk_bf16(b1[2], b1[3]); *(u32x4*)(r1 + bj * HALF) = v; } } }
        }
    }
};
struct EpiRes {
    static constexpr bool PERM = false, AFTER_DRAIN = false;
    const float* base; const bf16_t* bbase; float* out; bf16_t* xb; float* ss; float accscale;
    __device__ __forceinline__ void operator()(f32x4 (&acc)[2][2][4][2], const Unit& u, int wr, int wc, int fr, int fq) const {
        typedef unsigned u32x2v __attribute__((ext_vector_type(2)));
        const int col0 = u.pn * BM + wc * 32 + 4 * fq;
#pragma unroll
        for (int ai = 0; ai < 2; ++ai)
#pragma unroll
            for (int mp = 0; mp < 2; ++mp) {
                f32x4 bs[2][2][2];
#pragma unroll
                for (int mm = 0; mm < 2; ++mm) { const int m = 2 * mp + mm; const int row = u.pm * BM + ai * HALF + wr * 64 + m * 16 + fr; const size_t off = (size_t)row * 1024 + col0;
#pragma unroll
                    for (int bj = 0; bj < 2; ++bj)
#pragma unroll
                        for (int n = 0; n < 2; ++n) {
                            if (base) bs[mm][bj][n] = *(const f32x4*)(base + off + bj * HALF + n * 16);
                            else { const u32x2v w = *(const u32x2v*)(bbase + off + bj * HALF + n * 16); bs[mm][bj][n] = (f32x4){__builtin_bit_cast(float, w.x << 16), __builtin_bit_cast(float, w.x & 0xffff0000u), __builtin_bit_cast(float, w.y << 16), __builtin_bit_cast(float, w.y & 0xffff0000u)}; } } }
                asm volatile("" ::: "memory");
#pragma unroll
                for (int mm = 0; mm < 2; ++mm) { const int m = 2 * mp + mm; const int row = u.pm * BM + ai * HALF + wr * 64 + m * 16 + fr; const size_t off = (size_t)row * 1024 + col0; float q = 0.f;
#pragma unroll
                    for (int bj = 0; bj < 2; ++bj)
#pragma unroll
                        for (int n = 0; n < 2; ++n) { const f32x4 o = bs[mm][bj][n] + acc[ai][bj][m][n] * accscale;
                            if (out) *(f32x4*)(out + off + bj * HALF + n * 16) = o;
                            q += (o[0] * o[0] + o[1] * o[1]) + (o[2] * o[2] + o[3] * o[3]);
                            if (xb) { u32x2v w; w.x = cvt_pk_bf16(o[0], o[1]); w.y = cvt_pk_bf16(o[2], o[3]); *(u32x2v*)(xb + off + bj * HALF + n * 16) = w; } }
                    q = xsum<16>(q); q = xsum<32>(q);
                    if (fq == 0) ss[(size_t)row * 16 + u.pn * 4 + wc] = q; }
            }
    }
};
struct EpiResNorm {
    static constexpr bool PERM = false, AFTER_DRAIN = false;
    const bf16_t* bbase; float* out; float* ss; unsigned* cnt; const float* gfin; float accscale;
    __device__ __forceinline__ void operator()(f32x4 (&acc)[2][2][4][2], const Unit& u, int wr, int wc, int fr, int fq) const {
        typedef unsigned u32x2v __attribute__((ext_vector_type(2)));
        const int col0 = u.pn * BM + wc * 32 + 4 * fq;
#pragma unroll
        for (int ai = 0; ai < 2; ++ai)
#pragma unroll
            for (int m = 0; m < 4; ++m) { const int row = u.pm * BM + ai * HALF + wr * 64 + m * 16 + fr; const size_t off = (size_t)row * 1024 + col0; float q = 0.f;
#pragma unroll
                for (int bj = 0; bj < 2; ++bj)
#pragma unroll
                    for (int n = 0; n < 2; ++n) { const u32x2v w = *(const u32x2v*)(bbase + off + bj * HALF + n * 16);
                        const f32x4 bs = (f32x4){__builtin_bit_cast(float, w.x << 16), __builtin_bit_cast(float, w.x & 0xffff0000u), __builtin_bit_cast(float, w.y << 16), __builtin_bit_cast(float, w.y & 0xffff0000u)};
                        const f32x4 o = bs + acc[ai][bj][m][n] * accscale; acc[ai][bj][m][n] = o; q += (o[0] * o[0] + o[1] * o[1]) + (o[2] * o[2] + o[3] * o[3]); }
                q = xsum<16>(q); q = xsum<32>(q);
                if (fq == 0) __hip_atomic_store(ss + (size_t)row * 16 + u.pn * 4 + wc, q, __ATOMIC_RELAXED, __HIP_MEMORY_SCOPE_AGENT); }
        asm volatile("s_waitcnt vmcnt(0)" ::: "memory");
        unsigned* pc = cnt + 16 * u.pm;
        if ((threadIdx.x & 63) == 0) __hip_atomic_fetch_add(pc, 1u, __ATOMIC_RELAXED, __HIP_MEMORY_SCOPE_AGENT);
        for (unsigned sp = 0; sp < (1u << 22); ++sp) { if (__hip_atomic_load(pc, __ATOMIC_RELAXED, __HIP_MEMORY_SCOPE_AGENT) >= 32u * rounds) break; __builtin_amdgcn_s_sleep(2); }
        __builtin_amdgcn_fence(__ATOMIC_ACQUIRE, "agent"); asm volatile("s_waitcnt vmcnt(0)" ::: "memory");
        f32x4 gf[2][2];
#pragma unroll
        for (int bj = 0; bj < 2; ++bj)
#pragma unroll
            for (int n = 0; n < 2; ++n) gf[bj][n] = *(const f32x4*)(gfin + col0 + bj * HALF + n * 16);
        float part[2][4][4];
#pragma unroll
        for (int ai = 0; ai < 2; ++ai)
#pragma unroll
            for (int m = 0; m < 4; ++m) { const int row = u.pm * BM + ai * HALF + wr * 64 + m * 16 + fr; const float* sp = ss + (size_t)row * 16 + 4 * fq;
#pragma unroll
                for (int e = 0; e < 4; ++e) part[ai][m][e] = __hip_atomic_load(sp + e, __ATOMIC_RELAXED, __HIP_MEMORY_SCOPE_AGENT); }
#pragma unroll
        for (int ai = 0; ai < 2; ++ai)
#pragma unroll
            for (int m = 0; m < 4; ++m) { const int row = u.pm * BM + ai * HALF + wr * 64 + m * 16 + fr; const size_t off = (size_t)row * 1024 + col0;
                float s = (part[ai][m][0] + part[ai][m][1]) + (part[ai][m][2] + part[ai][m][3]);
                s = xsum<16>(s); s = xsum<32>(s);
                const float rstd = __builtin_amdgcn_rsqf(s * (1.0f / 1024.0f) + 1e-6f);
#pragma unroll
                for (int bj = 0; bj < 2; ++bj)
#pragma unroll
                    for (int n = 0; n < 2; ++n) *(f32x4*)(out + off + bj * HALF + n * 16) = acc[ai][bj][m][n] * rstd * gf[bj][n]; }
    }
    unsigned rounds;
};
struct EpiConv {
    static constexpr bool PERM = true, AFTER_DRAIN = false;
    const float* ss; const float* wconv; const float* bconv; bf16_t* G; float* halo; PG8_LAS float* xch;
    __device__ __forceinline__ void operator()(f32x4 (&acc)[2][2][4][2], const Unit& u, int wr_, int wc_, int fr_, int fq_) const {
        int t_ = threadIdx.x; asm volatile("" : "+v"(t_));
        const int wid_ = __builtin_amdgcn_readfirstlane(t_ >> 6), wr = wid_ >> 2, wc = wid_ & 3, fr = t_ & 15, fq = (t_ >> 4) & 3; (void)wr_; (void)wc_; (void)fr_; (void)fq_;
        const int beta = 16 * wr + fr; const unsigned tok0 = (unsigned)(u.pm * BM + 8 * beta);
        float rs[8];
        { const char* sp = (const char*)ss + (size_t)((tok0 * 16u + 4u * (unsigned)fq) * 4u);
#pragma unroll
        for (int j = 0; j < 8; ++j) { const f32x4 a = *(const f32x4*)(sp + j * 64); float s = (a[0] + a[1]) + (a[2] + a[3]);
            s = xsum<16>(s); s = xsum<32>(s);
            rs[j] = __builtin_amdgcn_rsqf(s * (1.0f / 1024.0f) + 1e-6f); } }
#pragma unroll
        for (int ai = 0; ai < 2; ++ai)
#pragma unroll
            for (int m = 0; m < 4; ++m)
#pragma unroll
                for (int bj = 0; bj < 2; ++bj)
#pragma unroll
                    for (int n = 0; n < 2; ++n) acc[ai][bj][m][n] = acc[ai][bj][m][n] * rs[m + 4 * ai];
        if (fr == 0) { PG8_LAS f32x4* d = (PG8_LAS f32x4*)(xch + ((((wr * 4 + wc) * 2 + 0) * 4 + fq) * 16));
            d[0] = acc[0][0][0][0]; d[1] = acc[0][0][0][1]; d[2] = acc[0][1][0][0]; d[3] = acc[0][1][0][1]; }
        if (fr == 15) { PG8_LAS f32x4* d = (PG8_LAS f32x4*)(xch + ((((wr * 4 + wc) * 2 + 1) * 4 + fq) * 16));
            d[0] = acc[1][0][3][0]; d[1] = acc[1][0][3][1]; d[2] = acc[1][1][3][0]; d[3] = acc[1][1][3][1]; }
        if (beta == 0 || beta == 31) { const int hr = beta == 0 ? 0 : 2; char* hp = (char*)halo + (size_t)((((unsigned)u.pm * 4u + (unsigned)hr) * 5632u + (unsigned)(u.pn * BM + wc * 32 + 8 * fq)) * 4u);
#pragma unroll
            for (int t = 0; t < 2; ++t)
#pragma unroll
                for (int bj = 0; bj < 2; ++bj)
#pragma unroll
                    for (int n = 0; n < 2; ++n) *(f32x4*)(hp + (t * 5632 + bj * HALF + 4 * n) * 4) = beta == 0 ? acc[0][bj][t][n] : acc[1][bj][2 + t][n]; }
        asm volatile("s_waitcnt lgkmcnt(0)\n\ts_barrier" ::: "memory");
        const unsigned jg0 = (unsigned)(u.pn * 128 + wc * 32 + 8 * fq);
#pragma unroll
        for (int n = 0; n < 2; ++n)
#pragma unroll
            for (int bj = 0; bj < 2; ++bj) {
                const unsigned jc = (jg0 + 4u * n + bj * 2816u) * 4u;
                const f32x4 w0 = *(const f32x4*)((const char*)wconv + (size_t)jc), w1 = *(const f32x4*)((const char*)wconv + (size_t)(jc + 5632u * 4u)), w2 = *(const f32x4*)((const char*)wconv + (size_t)(jc + 2u * 5632u * 4u)), bb = *(const f32x4*)((const char*)bconv + (size_t)jc);
                f32x4 prv, nxt;
#pragma unroll
                for (int e = 0; e < 4; ++e) { float pa, na; const float sa = acc[1][bj][3][n][e], sb = acc[0][bj][0][n][e];
                    asm volatile("s_nop 1\n\tv_mov_b32_dpp %0, %2 row_shr:1 row_mask:0xf bank_mask:0xf bound_ctrl:1\n\tv_mov_b32_dpp %1, %3 row_shl:1 row_mask:0xf bank_mask:0xf bound_ctrl:1" : "=&v"(pa), "=&v"(na) : "v"(sa), "v"(sb));
                    prv[e] = pa; nxt[e] = na; }
                if (fr == 0) { if (wr == 1) prv = *(const PG8_LAS f32x4*)(xch + ((((0 * 4 + wc) * 2 + 1) * 4 + fq) * 16) + bj * 8 + n * 4); }
                if (fr == 15) { if (wr == 0) nxt = *(const PG8_LAS f32x4*)(xch + ((((1 * 4 + wc) * 2 + 0) * 4 + fq) * 16) + bj * 8 + n * 4); }
                f32x4 old = prv;
#pragma unroll
                for (int j = 0; j < 8; ++j) { const f32x4 cu = acc[j >> 2][bj][j & 3][n]; const f32x4 dn = j == 7 ? nxt : acc[(j + 1) >> 2][bj][(j + 1) & 3][n];
                    acc[j >> 2][bj][j & 3][n] = w0 * old + w1 * cu + w2 * dn + bb; old = cu; }
            }
        unsigned goff = (tok0 * 2816u + jg0) * 2u;
#pragma unroll
        for (int j = 0; j < 8; ++j) { unsigned w[4];
#pragma unroll
            for (int n = 0; n < 2; ++n) { const f32x4 g = acc[j >> 2][0][j & 3][n], v = acc[j >> 2][1][j & 3][n]; float r[4];
#pragma unroll
                for (int e = 0; e < 4; ++e) r[e] = g[e] * __builtin_amdgcn_rcpf(1.0f + __builtin_amdgcn_exp2f(-1.4426950408889634f * g[e])) * v[e];
                w[2 * n] = cvt_pk_bf16(r[0], r[1]); w[2 * n + 1] = cvt_pk_bf16(r[2], r[3]); }
            *(u32x4*)((char*)G + (size_t)goff) = (u32x4){w[0], w[1], w[2], w[3]}; goff += 5632u; }
    }
};
template <class Epi, class Sched, bool ALIGN_EPI = false, bool SP2 = false, bool APERM = false>
__device__ __forceinline__ void gemm_phase(PG8_LAS unsigned char* lds, const Gemm g, const Sched& S, const Epi& E) {
    int tid = threadIdx.x; asm volatile("" : "+v"(tid)); const int wid = __builtin_amdgcn_readfirstlane(tid >> 6), lane = tid & 63, wr = wid >> 2, wc = wid & 3, fr = lane & 15, fq = lane >> 4;
    const int K = g.K, nt = K / BK;
    unsigned voffA[2], voffB[2];
#pragma unroll
    for (int i = 0; i < 2; ++i) { int R, C; stage_rc(tid * 16 + i * 8192, R, C); const int Rb = Epi::PERM ? ((R & ~31) + perm32(R & 31)) : R;
        const int Ra = APERM ? (8 * (16 * ((R >> 6) & 1) + (R & 15)) + ((R >> 4) & 3)) : R; voffA[i] = (unsigned)(Ra * K + C) * 2u; voffB[i] = (unsigned)(Rb * K + C) * 2u; }
    const size_t voffA_d = (size_t)(APERM ? 128 : 64) * K * 2, voffB_d = (size_t)64 * K * 2;
    const size_t kstep = (size_t)(BK * 2);
    const size_t hstep = (size_t)HALF * K * 2;
    const size_t tstep = 2 * hstep; const size_t hstepA = APERM ? (size_t)4 * K * 2 : hstep;
    const unsigned ldsw = (unsigned)wid * 1024u;
    const int aoff = lds_byte(wr * 64 + fr, fq * 8), boff = lds_byte(wc * 32 + fr, fq * 8);
#define PG8_SA(b, h) (((b) * 2 + (h)) * HTB)
#define PG8_SB(b, h) ((4 + (b) * 2 + (h)) * HTB)
#define PG8_STAGE(bufoff, gbase, voff) do { _Pragma("unroll") for (int _i = 0; _i < 2; ++_i) \
        __builtin_amdgcn_global_load_lds((const unsigned*)((const char*)(gbase) + (size_t)_i * voff##_d + (voff)[0]), (PG8_LAS unsigned*)(lds + (bufoff) + ldsw + _i * 8192), 16, 0, 0); } while (0)
#define PG8_LDA(dst, b, h) do { _Pragma("unroll") for (int m = 0; m < 4; ++m) _Pragma("unroll") for (int k = 0; k < 2; ++k) dst[m][k] = *(const PG8_LAS bf16x8*)(lds + PG8_SA(b, h) + aoff + m * 2048 + k * 1024); } while (0)
#define PG8_LDB(dst, b, h) do { _Pragma("unroll") for (int n = 0; n < 2; ++n) _Pragma("unroll") for (int k = 0; k < 2; ++k) dst[n][k] = *(const PG8_LAS bf16x8*)(lds + PG8_SB(b, h) + boff + n * 2048 + k * 1024); } while (0)
#define PG8_MMA(ai, bj, At, Bt) do { __builtin_amdgcn_s_setprio(1); _Pragma("unroll") for (int m = 0; m < 4; ++m) _Pragma("unroll") for (int n = 0; n < 2; ++n) _Pragma("unroll") for (int k = 0; k < 2; ++k) \
        acc[ai][bj][m][n] = __builtin_amdgcn_mfma_f32_16x16x32_bf16(Bt[n][k], At[m][k], acc[ai][bj][m][n], 0, 0, 0); __builtin_amdgcn_s_setprio(0); } while (0)
#define PG8_WAIT_V(n) asm volatile("s_waitcnt vmcnt(" #n ")" ::: "memory")
#define PG8_WAIT_L(n) asm volatile("s_waitcnt lgkmcnt(" #n ")" ::: "memory")
#define PG8_BAR __builtin_amdgcn_s_barrier()
#define PG8_SCHED __builtin_amdgcn_sched_barrier(0)
    Unit cur, nxt; int ui = 0;
    if (!S.next(0, cur)) return;
    f32x4 acc[2][2][4][2];
#pragma unroll
    for (int a = 0; a < 2; ++a)
#pragma unroll
        for (int b = 0; b < 2; ++b)
#pragma unroll
            for (int m = 0; m < 4; ++m)
#pragma unroll
                for (int n = 0; n < 2; ++n) acc[a][b][m][n] = (f32x4){0.f, 0.f, 0.f, 0.f};
    bf16x8 At[4][2], B0[2][2], B1[2][2];
    const char* cA = (const char*)g.A + (size_t)cur.pm * tstep; const char* cB = (const char*)(cur.pm >= g.pm_split ? g.Bt2 : g.Bt) + (size_t)cur.pn * tstep;
    S.a_ready(cur);
    if constexpr (SP2) {
        PG8_STAGE(PG8_SB(0, 0), cB, voffB); PG8_STAGE(PG8_SB(0, 1), cB + hstep, voffB); PG8_STAGE(PG8_SA(0, 0), cA, voffA); PG8_STAGE(PG8_SA(0, 1), cA + hstepA, voffA);
        if (wr == 1) PG8_BAR;
        PG8_WAIT_V(2); PG8_BAR;
        PG8_STAGE(PG8_SB(1, 0), cB + kstep, voffB); PG8_STAGE(PG8_SA(1, 0), cA + kstep, voffA); PG8_STAGE(PG8_SB(1, 1), cB + hstep + kstep, voffB);
        PG8_WAIT_V(6); PG8_BAR;
    } else {
        PG8_STAGE(PG8_SB(0, 0), cB, voffB); PG8_STAGE(PG8_SA(0, 0), cA, voffA); PG8_STAGE(PG8_SB(0, 1), cB + hstep, voffB); PG8_STAGE(PG8_SA(0, 1), cA + hstepA, voffA);
        if (wr == 1) PG8_BAR;
        PG8_WAIT_V(4); PG8_BAR;
        PG8_STAGE(PG8_SB(1, 0), cB + kstep, voffB); PG8_STAGE(PG8_SA(1, 0), cA + kstep, voffA); PG8_STAGE(PG8_SB(1, 1), cB + hstep + kstep, voffB);
        PG8_WAIT_V(6); PG8_BAR;
    }
    for (;;) {
        const bool has_next = S.next(ui + 1, nxt);
        const char* nA = has_next ? (const char*)g.A + (size_t)nxt.pm * tstep : cA; const char* nB = has_next ? (const char*)(nxt.pm >= g.pm_split ? g.Bt2 : g.Bt) + (size_t)nxt.pn * tstep : cB;
        for (int t = 0; t < nt; t += 2) {
            const bool last = (t == nt - 2);
            const char* a1 = cA + (size_t)(t + 1) * kstep;
            const char* a2 = last ? nA : cA + (size_t)(t + 2) * kstep; const char* b2 = last ? nB : cB + (size_t)(t + 2) * kstep;
            const char* a3 = a2 + kstep; const char* b3 = b2 + kstep;
            if (last && has_next) S.a_ready(nxt);
            if constexpr (SP2) {
            PG8_LDB(B0, 0, 0); PG8_LDB(B1, 0, 1); PG8_SCHED; PG8_LDA(At, 0, 0); PG8_STAGE(PG8_SA(1, 1), a1 + hstepA, voffA);
            PG8_WAIT_V(8); PG8_WAIT_L(0); PG8_BAR; PG8_MMA(0, 0, At, B0); PG8_MMA(0, 1, At, B1); PG8_BAR; PG8_SCHED;
            PG8_LDA(At, 0, 1); PG8_STAGE(PG8_SB(0, 0), b2, voffB); PG8_STAGE(PG8_SB(0, 1), b2 + hstep, voffB); PG8_STAGE(PG8_SA(0, 0), a2, voffA);
            PG8_WAIT_V(8); PG8_WAIT_L(0); PG8_BAR; PG8_MMA(1, 0, At, B0); PG8_MMA(1, 1, At, B1); PG8_BAR; PG8_SCHED;
            PG8_LDB(B0, 1, 0); PG8_LDB(B1, 1, 1); PG8_SCHED; PG8_LDA(At, 1, 0); PG8_STAGE(PG8_SA(0, 1), a2 + hstepA, voffA);
            PG8_WAIT_V(8); PG8_WAIT_L(0); PG8_BAR; PG8_MMA(0, 0, At, B0); PG8_MMA(0, 1, At, B1); PG8_BAR; PG8_SCHED;
            PG8_LDA(At, 1, 1); PG8_STAGE(PG8_SB(1, 0), b3, voffB); PG8_STAGE(PG8_SB(1, 1), b3 + hstep, voffB); PG8_STAGE(PG8_SA(1, 0), a3, voffA);
            PG8_WAIT_V(8); PG8_WAIT_L(0); PG8_BAR; PG8_MMA(1, 0, At, B0); PG8_MMA(1, 1, At, B1); PG8_BAR; PG8_SCHED;
            } else {
            PG8_LDB(B0, 0, 0); PG8_SCHED; PG8_LDA(At, 0, 0); PG8_STAGE(PG8_SA(1, 1), a1 + hstepA, voffA);
            PG8_WAIT_L(8); PG8_BAR; PG8_WAIT_L(0); PG8_MMA(0, 0, At, B0); PG8_BAR; PG8_SCHED;
            PG8_LDB(B1, 0, 1); PG8_STAGE(PG8_SB(0, 0), b2, voffB);
            PG8_BAR; PG8_WAIT_L(0); PG8_MMA(0, 1, At, B1); PG8_BAR;
            PG8_LDA(At, 0, 1); PG8_STAGE(PG8_SA(0, 0), a2, voffA);
            PG8_BAR; PG8_WAIT_L(0); PG8_MMA(1, 0, At, B0); PG8_BAR; PG8_SCHED;
            PG8_STAGE(PG8_SB(0, 1), b2 + hstep, voffB);
            PG8_WAIT_V(6); PG8_BAR; PG8_MMA(1, 1, At, B1); PG8_BAR;
            PG8_LDB(B0, 1, 0); PG8_SCHED; PG8_LDA(At, 1, 0); PG8_STAGE(PG8_SA(0, 1), a2 + hstepA, voffA);
            PG8_WAIT_L(8); PG8_BAR; PG8_WAIT_L(0); PG8_MMA(0, 0, At, B0); PG8_BAR; PG8_SCHED;
            PG8_LDB(B1, 1, 1); PG8_STAGE(PG8_SB(1, 0), b3, voffB);
            PG8_BAR; PG8_WAIT_L(0); PG8_MMA(0, 1, At, B1); PG8_BAR;
            PG8_LDA(At, 1, 1); PG8_STAGE(PG8_SA(1, 0), a3, voffA);
            PG8_BAR; PG8_WAIT_L(0); PG8_MMA(1, 0, At, B0); PG8_BAR; PG8_SCHED;
            PG8_STAGE(PG8_SB(1, 1), b3 + hstep, voffB);
            PG8_WAIT_V(6); PG8_BAR; PG8_MMA(1, 1, At, B1); PG8_BAR;
            }
        }
        if constexpr (ALIGN_EPI) { if (wr == 0) PG8_BAR; }
        if constexpr (!Epi::AFTER_DRAIN) { E(acc, cur, wr, wc, fr, fq); S.done(cur); }
        if (!has_next) break;
#pragma unroll
        for (int a = 0; a < 2; ++a)
#pragma unroll
            for (int b = 0; b < 2; ++b)
#pragma unroll
                for (int m = 0; m < 4; ++m)
#pragma unroll
                    for (int n = 0; n < 2; ++n) acc[a][b][m][n] = (f32x4){0.f, 0.f, 0.f, 0.f};
        cur = nxt; cA = nA; cB = nB; ++ui;
        if constexpr (ALIGN_EPI) { if (wr == 1) PG8_BAR; }
    }
    PG8_WAIT_V(0);
    if constexpr (!ALIGN_EPI) { if (wr == 0) PG8_BAR; }
    PG8_BAR;
    if constexpr (Epi::AFTER_DRAIN) { E.fused(acc, cur, wr, wc, fr, fq, lds, wid, lane); S.done(cur); }
#undef PG8_SA
#undef PG8_SB
#undef PG8_STAGE
#undef PG8_LDA
#undef PG8_LDB
#undef PG8_MMA
#undef PG8_WAIT_V
#undef PG8_WAIT_L
#undef PG8_BAR
#undef PG8_SCHED
}
}
namespace att {
#define LAS __attribute__((address_space(3)))
typedef unsigned short bf16_t;
typedef short bf16x8 __attribute__((ext_vector_type(8)));
typedef short s16x4 __attribute__((ext_vector_type(4)));
typedef float f32x16 __attribute__((ext_vector_type(16)));
typedef float f32x4 __attribute__((ext_vector_type(4)));
typedef unsigned u32x2 __attribute__((ext_vector_type(2)));
constexpr int SEQ = 4096, KVB = 64, NT = SEQ / KVB, KBUFB = 16384, VOFFB = 32768, QOFFB = 65536;
constexpr float LOG2E = 1.4426950408889634f;
__device__ __forceinline__ unsigned cvtpk(float lo, float hi) { unsigned r; asm volatile("v_cvt_pk_bf16_f32 %0, %1, %2" : "=v"(r) : "v"(lo), "v"(hi)); return r; }
__device__ __forceinline__ float swapmax(float v) { float a = v, b = v; asm volatile("s_nop 1\n\tv_permlane32_swap_b32 %0, %1" : "+v"(a), "+v"(b)); return fmaxf(a, b); }
__device__ __forceinline__ float swapsum(float v) { float a = v, b = v; asm volatile("s_nop 1\n\tv_permlane32_swap_b32 %0, %1" : "+v"(a), "+v"(b)); return a + b; }


__device__ __forceinline__ void kmax_slice(LAS unsigned char* lds, const bf16_t* __restrict__ QK, unsigned* KSH, int bh, int slice) {
    const int tid = threadIdx.x, lane = tid & 63; const int wid = __builtin_amdgcn_readfirstlane(tid >> 6);
    const bf16_t* Kn = QK + (size_t)(bh >> 2) * SEQ * 1024 + 512 + (bh & 3) * 128 + (size_t)slice * 512 * 1024; float kn2 = 0.f;
    for (int i0 = 0; i0 < 16; i0 += 8) { bf16x8 kv16[8];
#pragma unroll
        for (int u = 0; u < 8; ++u) kv16[u] = *(const bf16x8*)(Kn + (size_t)((wid * 16 + i0 + u) * 4 + (lane >> 4)) * 1024 + (lane & 15) * 8);
#pragma unroll
        for (int u = 0; u < 8; ++u) { float a = 0.f;
#pragma unroll
            for (int e = 0; e < 8; ++e) { const float f = __builtin_bit_cast(float, (unsigned)(unsigned short)kv16[u][e] << 16); a += f * f; }
            a += __builtin_bit_cast(float, __builtin_amdgcn_ds_swizzle(__builtin_bit_cast(int, a), (1 << 10) | 0x1f)); a += __builtin_bit_cast(float, __builtin_amdgcn_ds_swizzle(__builtin_bit_cast(int, a), (2 << 10) | 0x1f));
            a += __builtin_bit_cast(float, __builtin_amdgcn_ds_swizzle(__builtin_bit_cast(int, a), (4 << 10) | 0x1f)); kn2 = fmaxf(kn2, a); } }
#define ATT_SWZMAX(v, K_) v = fmaxf(v, __builtin_bit_cast(float, __builtin_amdgcn_ds_swizzle(__builtin_bit_cast(int, v), ((K_) << 10) | 0x1f)))
    ATT_SWZMAX(kn2, 1); ATT_SWZMAX(kn2, 2); ATT_SWZMAX(kn2, 4); ATT_SWZMAX(kn2, 8); ATT_SWZMAX(kn2, 16);
#undef ATT_SWZMAX
    kn2 = swapmax(kn2);
    LAS float* red = (LAS float*)(lds + 131072);
    if (lane == 0) red[wid] = kn2;
    asm volatile("s_waitcnt lgkmcnt(0)\n\ts_barrier" ::: "memory");
    if (tid == 0) { float km = 0.f; for (int w = 0; w < 8; ++w) km = fmaxf(km, red[w]);
        __hip_atomic_fetch_max(KSH + bh, __builtin_bit_cast(unsigned, km), __ATOMIC_RELAXED, __HIP_MEMORY_SCOPE_AGENT);
        __builtin_amdgcn_fence(__ATOMIC_RELEASE, "agent"); asm volatile("s_waitcnt vmcnt(0)" ::: "memory");
        __hip_atomic_fetch_add(KSH + 64 + bh, 1u, __ATOMIC_RELAXED, __HIP_MEMORY_SCOPE_AGENT); }
    asm volatile("s_waitcnt lgkmcnt(0)\n\ts_barrier" ::: "memory");
}
__device__ __forceinline__ void attn_unit(LAS unsigned char* lds, const bf16_t* __restrict__ QK, const bf16_t* __restrict__ VT, bf16_t* __restrict__ MIX, const float* __restrict__ gsub, float lam, int b, int h, int qb, unsigned* KSH) {
    int tid = threadIdx.x; asm volatile("" : "+v"(tid));
    const int lane = tid & 63, r32 = lane & 31, hi = lane >> 5; const int wid = __builtin_amdgcn_readfirstlane(tid >> 6);
    const float slope2 = __builtin_amdgcn_exp2f(-2.0f * (float)(h + 1)) * LOG2E;
    const int qpos = qb * 256 + wid * 32 + r32;
    int t_lo, t_hi;
    { float kn2 = 0.f, qn2 = 0.f;
      const bf16_t* Kn = QK + (size_t)b * SEQ * 1024 + 512 + h * 128;
      if (!KSH) for (int i0 = 0; i0 < 128; i0 += 8) { bf16x8 kv16[8];
#pragma unroll
          for (int u = 0; u < 8; ++u) kv16[u] = *(const bf16x8*)(Kn + (size_t)((wid * 128 + i0 + u) * 4 + (lane >> 4)) * 1024 + (lane & 15) * 8);
#pragma unroll
          for (int u = 0; u < 8; ++u) { float a = 0.f;
#pragma unroll
              for (int e = 0; e < 8; ++e) { const float f = __builtin_bit_cast(float, (unsigned)(unsigned short)kv16[u][e] << 16); a += f * f; }
              a += __builtin_bit_cast(float, __builtin_amdgcn_ds_swizzle(__builtin_bit_cast(int, a), (1 << 10) | 0x1f)); a += __builtin_bit_cast(float, __builtin_amdgcn_ds_swizzle(__builtin_bit_cast(int, a), (2 << 10) | 0x1f));
              a += __builtin_bit_cast(float, __builtin_amdgcn_ds_swizzle(__builtin_bit_cast(int, a), (4 << 10) | 0x1f)); kn2 = fmaxf(kn2, a); } }
      float qa1 = 0.f, qa2 = 0.f, sd1 = 0.f, sd2 = 0.f;
      if (tid < 256) { const bf16x8* qr = (const bf16x8*)(QK + (size_t)(b * SEQ + qb * 256 + tid) * 1024 + h * 128); const bf16x8* kr = (const bf16x8*)(QK + (size_t)(b * SEQ + qb * 256 + tid) * 1024 + 512 + h * 128);
#pragma unroll
          for (int c = 0; c < 16; ++c) { const bf16x8 v = qr[c], w = kr[c]; float a = 0.f, d = 0.f;
#pragma unroll
              for (int e = 0; e < 8; ++e) { const float f = __builtin_bit_cast(float, (unsigned)(unsigned short)v[e] << 16), g = __builtin_bit_cast(float, (unsigned)(unsigned short)w[e] << 16); a += f * f; d += f * g; }
              if (c < 8) { qa1 += a; sd1 += d; } else { qa2 += a; sd2 += d; } } }
#define ATT_SWZMAX(v, K_) v = fmaxf(v, __builtin_bit_cast(float, __builtin_amdgcn_ds_swizzle(__builtin_bit_cast(int, v), ((K_) << 10) | 0x1f)))
      ATT_SWZMAX(kn2, 1); ATT_SWZMAX(kn2, 2); ATT_SWZMAX(kn2, 4); ATT_SWZMAX(kn2, 8); ATT_SWZMAX(kn2, 16);
      kn2 = swapmax(kn2);
      LAS float* red = (LAS float*)(lds + 131072);
      if (lane == 0) red[wid] = kn2;
      asm volatile("s_waitcnt lgkmcnt(0)\n\ts_barrier" ::: "memory");
      float km = 0.f;
#pragma unroll
      for (int w = 0; w < 8; ++w) km = fmaxf(km, red[w]);
      if (KSH) {
          unsigned* kc = KSH + 64 + (b * 4 + h);
          for (unsigned sp = 0; sp < (1u << 22); ++sp) { if (__hip_atomic_load(kc, __ATOMIC_RELAXED, __HIP_MEMORY_SCOPE_AGENT) >= 8u) break; __builtin_amdgcn_s_sleep(2); }
          __builtin_amdgcn_fence(__ATOMIC_ACQUIRE, "agent");
          km = __builtin_bit_cast(float, __hip_atomic_load(KSH + (b * 4 + h), __ATOMIC_RELAXED, __HIP_MEMORY_SCOPE_AGENT)); }
      float rr_ = tid < 256 ? fmaxf(sqrtf(qa1 * km) * 1.01f - sd1, sqrtf(qa2 * km) * 1.01f - sd2) : 0.f;
      if (tid < 256) { red[64 + tid] = fminf(sqrtf(qa1 * km) * 1.01f + 0.01f, sd1 + 100.0f); red[320 + tid] = fminf(sqrtf(qa2 * km) * 1.01f + 0.01f, sd2 + 100.0f); }
      ATT_SWZMAX(rr_, 1); ATT_SWZMAX(rr_, 2); ATT_SWZMAX(rr_, 4); ATT_SWZMAX(rr_, 8); ATT_SWZMAX(rr_, 16);
#undef ATT_SWZMAX
      rr_ = swapmax(rr_);
      if (lane == 0) red[8 + wid] = rr_;
      asm volatile("s_waitcnt lgkmcnt(0)\n\ts_barrier" ::: "memory");
      float rm = 0.f;
#pragma unroll
      for (int w = 0; w < 8; ++w) rm = fmaxf(rm, red[8 + w]);
      asm volatile("s_waitcnt lgkmcnt(0)\n\ts_barrier" ::: "memory");
      const float dm = (rm + 0.05f + 32.0f) / slope2;
      const int dmi = dm < 8192.0f ? (int)dm + 2 : 8192;
      const int q0 = qb * 256; int lo = q0 - dmi; if (lo < 0) lo = 0; int hk = q0 + 255 + dmi; if (hk > SEQ - 1) hk = SEQ - 1;
      t_lo = __builtin_amdgcn_readfirstlane(lo >> 6); t_hi = __builtin_amdgcn_readfirstlane(hk >> 6); }
    { const char* Qg = (const char*)(QK + (size_t)(b * SEQ + qb * 256 + wid * 32) * 1024 + h * 128);
#pragma unroll
      for (int p = 0; p < 8; ++p) { const int row = 4 * p + (lane >> 4); const int c = (lane & 15) ^ (row & 15);
          __builtin_amdgcn_global_load_lds((const unsigned*)(Qg + (size_t)(row * 2048 + c * 16)), (LAS unsigned*)(lds + QOFFB + wid * 8192 + p * 1024), 16, 0, 0); } }
    const char* Kg = (const char*)(QK + (size_t)b * SEQ * 1024 + 512 + h * 128);
    const char* Vg = (const char*)(VT + (size_t)(b * 512 + h * 128) * 4096);
    unsigned koff[2], voff[2];
#pragma unroll
    for (int i = 0; i < 2; ++i) { const int p = wid + 8 * i; const int row = 4 * p + (lane >> 4); const int c = (lane & 15) ^ (row & 15); koff[i] = (unsigned)(row * 2048 + c * 16);
        const int dv = 8 * p + (lane >> 3); const int j = (lane & 7) ^ ((dv >> 1) & 7); voff[i] = (unsigned)(dv * 8192 + j * 16); }
#define ATT_DMA(t, buf) do { _Pragma("unroll") for (int i_ = 0; i_ < 2; ++i_) { \
        __builtin_amdgcn_global_load_lds((const unsigned*)(Kg + (size_t)(t) * (KVB * 2048) + koff[i_]), (LAS unsigned*)(lds + (buf) * KBUFB + (wid + 8 * i_) * 1024), 16, 0, 0); \
        __builtin_amdgcn_global_load_lds((const unsigned*)(Vg + (size_t)(t) * (KVB * 2) + voff[i_]), (LAS unsigned*)(lds + VOFFB + (buf) * KBUFB + (wid + 8 * i_) * 1024), 16, 0, 0); } } while (0)
    f32x16 O[2][4];
#pragma unroll
    for (int c = 0; c < 2; ++c)
#pragma unroll
        for (int k = 0; k < 4; ++k) O[c][k] = f32x16{};
    float lrun[2] = {0.f, 0.f};
    const LAS unsigned char* Qb = lds + QOFFB + wid * 8192;
    ATT_DMA(t_lo, t_lo & 1);
    for (int t = t_lo; t <= t_hi; ++t) {
        asm volatile("s_waitcnt vmcnt(0)\n\ts_barrier" ::: "memory");
        if (t < t_hi) ATT_DMA(t + 1, (t + 1) & 1);
        int ln_ = lane; asm volatile("" : "+v"(ln_));
        const int r32 = ln_ & 31, hi = ln_ >> 5;
        const int rp = (r32 & ~12) | ((r32 & 4) << 1) | ((r32 & 8) >> 1);
        const int ksw = r32 & 15; const int kbase = r32 * 256; const int kswp = rp & 15; const int kbasep = rp * 256; const int vsw = (r32 >> 1) & 7; const int vbase = r32 * 128;
        const LAS unsigned char* Kb = lds + (t & 1) * KBUFB; const LAS unsigned char* Vb = lds + VOFFB + (t & 1) * KBUFB;
        const float dq = (float)(qpos - t * KVB - 8 * hi);
        float mfix[2]; { const LAS float* red2 = (const LAS float*)(lds + 131072); mfix[0] = red2[64 + wid * 32 + r32]; mfix[1] = red2[320 + wid * 32 + r32]; }
#pragma unroll
        for (int c = 0; c < 2; ++c) {
        bf16x8 qv4[4];
#pragma unroll
        for (int d0 = 0; d0 < 4; ++d0) qv4[d0] = *(const LAS bf16x8*)(Qb + kbase + (((c * 8 + d0 * 2 + hi) ^ ksw) * 16));
#pragma unroll
        for (int hf = 0; hf < 2; ++hf) {
            bf16x8 pk[2];
            {
            f32x16 p0 = f32x16{};
            {
                bf16x8 ka[4];
#pragma unroll
                for (int d0 = 0; d0 < 4; ++d0) ka[d0] = *(const LAS bf16x8*)(Kb + kbasep + (((c * 8 + d0 * 2 + hi) ^ kswp) * 16) + hf * 8192);
                asm volatile("" : "+v"(ka[0]), "+v"(ka[1]), "+v"(ka[2]), "+v"(ka[3]));
#pragma unroll
                for (int d0 = 0; d0 < 4; ++d0) p0 = __builtin_amdgcn_mfma_f32_32x32x16_bf16(ka[d0], qv4[d0], p0, 0, 0, 0);
            }
            float s = 0.f;
#pragma unroll
            for (int r = 0; r < 16; ++r) { const float cr = (float)((r & 7) + 16 * (r >> 3) + 32 * hf);
                p0[r] = __builtin_amdgcn_exp2f((p0[r] - slope2 * fabsf(dq - cr)) - mfix[c]); s += p0[r]; if ((r & 3) == 3) asm volatile("" : "+v"(s)); }
            lrun[c] += s;
#pragma unroll
            for (int k2 = 0; k2 < 2; ++k2) {
                typedef unsigned u32x4v __attribute__((ext_vector_type(4)));
                u32x4v w0;
                w0.x = cvtpk(p0[8 * k2 + 0], p0[8 * k2 + 1]); w0.y = cvtpk(p0[8 * k2 + 2], p0[8 * k2 + 3]); w0.z = cvtpk(p0[8 * k2 + 4], p0[8 * k2 + 5]); w0.w = cvtpk(p0[8 * k2 + 6], p0[8 * k2 + 7]);
                pk[k2] = __builtin_bit_cast(bf16x8, w0); }
            }
#pragma unroll
            for (int bp = 0; bp < 2; ++bp) {
                bf16x8 vq[4];
#pragma unroll
                for (int u = 0; u < 4; ++u) vq[u] = *(const LAS bf16x8*)(Vb + (2 * bp + (u >> 1)) * 4096 + vbase + (((2 * (2 * hf + (u & 1)) + hi) ^ vsw) * 16));
                asm volatile("" : "+v"(vq[0]), "+v"(vq[1]), "+v"(vq[2]), "+v"(vq[3]));
#pragma unroll
                for (int u = 0; u < 4; ++u) O[c][2 * bp + (u >> 1)] = __builtin_amdgcn_mfma_f32_32x32x16_bf16(vq[u], pk[u & 1], O[c][2 * bp + (u >> 1)], 0, 0, 0);
            }
        }
        }
    }
#undef ATT_DMA
    const float i1 = 1.0f / swapsum(lrun[0]), i2 = lam / swapsum(lrun[1]);
    float ssq = 0.f;
#pragma unroll
    for (int k = 0; k < 4; ++k)
#pragma unroll
        for (int r = 0; r < 16; ++r) { const float o = O[0][k][r] * i1 - O[1][k][r] * i2; O[0][k][r] = o; ssq += o * o; }
    ssq = swapsum(ssq);
    const float rn = __builtin_amdgcn_rsqf(ssq * (1.0f / 128.0f) + 1e-5f) * 0.8f * ABL_ATT;
    bf16_t* orow = MIX + (size_t)(b * SEQ + qpos) * 1024 + h * 128;
#pragma unroll
    for (int k = 0; k < 4; ++k)
#pragma unroll
        for (int g = 0; g < 4; ++g) { const int dv = 32 * k + 8 * g + 4 * hi; const f32x4 gs = *(const f32x4*)(gsub + dv);
            u32x2 w; w.x = cvtpk(O[0][k][4 * g] * rn * gs[0], O[0][k][4 * g + 1] * rn * gs[1]); w.y = cvtpk(O[0][k][4 * g + 2] * rn * gs[2], O[0][k][4 * g + 3] * rn * gs[3]);
            *(u32x2*)(orow + dv) = w; }
}
#undef LAS
}
#define GAS __attribute__((address_space(1)))
#define LAS __attribute__((address_space(3)))
typedef unsigned short bf16;
typedef unsigned v4u __attribute__((ext_vector_type(4)));
typedef float f32x4 __attribute__((ext_vector_type(4)));
constexpr int NWAVES = 8;
constexpr int BATCH = 8, SEQ = 4096, DM = 1024, MTOK = BATCH * SEQ, DFF = 2816, NUP = 2 * DFF;
constexpr size_t MiB = 1u << 20;
constexpr size_t WS_WQK = 2 * MiB, WS_WVAB = 4 * MiB, WS_WOUT = 8 * MiB, WS_WUP = 10 * MiB, WS_WDOWN = 22 * MiB, WS_SS1 = 28 * MiB, WS_SS2 = 30 * MiB, WS_HALO = 32 * MiB;
constexpr size_t WS_XN = 48 * MiB, WS_QK = 112 * MiB, WS_VT = 176 * MiB, WS_T = 208 * MiB, WS_DFT = 272 * MiB, WS_MIX = 336 * MiB, WS_XB2 = 400 * MiB, WS_G = 48 * MiB, WS_PBUF = 464 * MiB, WS_END = 496 * MiB;
constexpr int RING_BYTES = 131072, XCH_OFF = RING_BYTES, TAB_OFF = RING_BYTES + 4096, LDS_BYTES = 147456;

__device__ __forceinline__ unsigned f2bf(float f) { unsigned u = __builtin_bit_cast(unsigned, f); return (u + 0x7fffu + ((u >> 16) & 1u)) >> 16; }
__device__ __forceinline__ unsigned pk2(float lo, float hi) { return f2bf(lo) | (f2bf(hi) << 16); }
__device__ __forceinline__ float wave_sum(float v) { v = pg8::xsum<1>(v); v = pg8::xsum<2>(v); v = pg8::xsum<4>(v); v = pg8::xsum<8>(v); v = pg8::xsum<16>(v); v = pg8::xsum<32>(v); return v; }
__device__ __forceinline__ void tr_item(const float* W, int ldw, int k0, int sc0, const float* ks, float nscale, bf16* dst, int ldd, int n0, LAS float* scr, int lane) {
#pragma unroll
    for (int i = 0; i < 32; ++i) { const int kk = 2 * i + (lane >> 5); float v = W[(size_t)(k0 + kk) * ldw + sc0 + (lane & 31)] * nscale; if (ks) v *= ks[k0 + kk]; scr[kk * 33 + (lane & 31)] = v; }
    asm volatile("s_waitcnt lgkmcnt(0)" ::: "memory");
    const int c = lane & 7;
#pragma unroll
    for (int j = 0; j < 4; ++j) { const int n = (lane >> 3) + 8 * j; const LAS float* s = scr + (8 * c) * 33 + n;
        v4u o; o.x = pk2(s[0 * 33], s[1 * 33]); o.y = pk2(s[2 * 33], s[3 * 33]); o.z = pk2(s[4 * 33], s[5 * 33]); o.w = pk2(s[6 * 33], s[7 * 33]);
        *(v4u*)(dst + (size_t)(n0 + n) * ldd + k0 + 8 * c) = o; }
    asm volatile("s_waitcnt lgkmcnt(0)" ::: "memory");
}


#define XB_TMO      128
#define XB_XCNT(j)  (256  + 64 * (j))
#define XB_XSUB(j)  (1280 + 64 * (j))
#define XB_XGEN(j)  (2304 + 64 * (j))
#define XB_TOP      3328
#define XB_TOPGEN   3392
#define XCD_BAR_WORDS 3456
#define XB_SPIN_CAP (1u << 18)

__device__ __forceinline__ unsigned xb_ld(unsigned* p)              { return __hip_atomic_load(p, __ATOMIC_RELAXED, __HIP_MEMORY_SCOPE_AGENT); }
__device__ __forceinline__ unsigned xb_add(unsigned* p, unsigned v) { return __hip_atomic_fetch_add(p, v, __ATOMIC_RELAXED, __HIP_MEMORY_SCOPE_AGENT); }
__device__ __forceinline__ unsigned xb_xcc_id() { return (unsigned)__builtin_amdgcn_s_getreg((3 << 11) | 20) & 0xFu; }
#define XB_SPIN(cond, bar) do { unsigned _sp = 0; while (cond) { __builtin_amdgcn_s_sleep(1); \
    if ((++_sp & 255u) == 0u) { if (xb_ld(&(bar)[XB_TMO])) break; if (_sp > XB_SPIN_CAP) { atomicAdd(&(bar)[XB_TMO], 1u); break; } } } } while (0)

struct XcdBarrier {
    unsigned* bar; unsigned x;
    volatile LAS unsigned* st;
};

__device__ __forceinline__ XcdBarrier xcd_barrier_post(unsigned* bar, volatile LAS unsigned* st) {
    XcdBarrier b; b.bar = bar; b.x = xb_xcc_id(); b.st = st;
    if (threadIdx.x == 0) (void)xb_add(&bar[XB_XCNT(b.x)], 1u);
    return b;
}
__device__ __forceinline__ void xcd_barrier_complete(unsigned* bar, unsigned x, unsigned& nloc, unsigned& nx) {
    const unsigned G = gridDim.x * gridDim.y * gridDim.z;
    unsigned sum, cnt, mine, sp = 0u;
    for (;;) {
        sum = 0u; cnt = 0u; mine = 0u;
#pragma unroll
        for (unsigned j = 0; j < 16; ++j) { const unsigned c = xb_ld(&bar[XB_XCNT(j)]); sum += c; cnt += (c > 0u) ? 1u : 0u; mine = (j == x) ? c : mine; }
        if (sum == G) break;
        __builtin_amdgcn_s_sleep(1);
        if ((++sp & 255u) == 0u) { if (xb_ld(&bar[XB_TMO])) break; if (sp > XB_SPIN_CAP) { atomicAdd(&bar[XB_TMO], 1u); break; } }
    }
    nloc = mine > 0u ? mine : 1u; nx = cnt > 0u ? cnt : 1u;
}

__device__ __forceinline__ void xcd_barrier(const XcdBarrier& b) {
    asm volatile("s_waitcnt vmcnt(0)" ::: "memory");
    __syncthreads();
    if (threadIdx.x == 0) {
        unsigned* bar = b.bar;
        __builtin_amdgcn_s_waitcnt(0);
        unsigned nloc = b.st[0], nx = b.st[1];
        if (nloc == 0u) { xcd_barrier_complete(bar, b.x, nloc, nx); b.st[0] = nloc; b.st[1] = nx; }
        const unsigned old = xb_add(&bar[XB_XSUB(b.x)], 1u);
        const unsigned gen = old / nloc;
        if (old + 1u == (gen + 1u) * nloc) {
            __builtin_amdgcn_fence(__ATOMIC_RELEASE, "agent");
            asm volatile("s_waitcnt vmcnt(0)" ::: "memory");
            const unsigned og = xb_add(&bar[XB_TOP], 1u);
            const unsigned tg = og / nx;
            if (og + 1u == (tg + 1u) * nx) xb_add(&bar[XB_TOPGEN], 1u);
            else XB_SPIN(xb_ld(&bar[XB_TOPGEN]) == tg, bar);
            __builtin_amdgcn_fence(__ATOMIC_ACQUIRE, "agent");
            xb_add(&bar[XB_XGEN(b.x)], 1u);
            asm volatile("s_waitcnt vmcnt(0)" ::: "memory");
        } else {
            XB_SPIN(xb_ld(&bar[XB_XGEN(b.x)]) == gen, bar);
            __builtin_amdgcn_fence(__ATOMIC_ACQUIRE, "agent");
            asm volatile("s_waitcnt vmcnt(0)" ::: "memory");
        }
    }
    __syncthreads();
}


#ifndef PROBE
#define PROBE 0
#endif
#if PROBE
__device__ __forceinline__ float bf2f(bf16 v) { return __builtin_bit_cast(float, (unsigned)v << 16); }
__device__ __forceinline__ unsigned hash32(unsigned x) { x ^= x >> 16; x *= 0x7feb352dU; x ^= x >> 15; x *= 0x846ca68bU; x ^= x >> 16; return x; }
__device__ __forceinline__ float wdot_bf(const bf16* a, const bf16* b, int K, int lane) { float s = 0.f; for (int k = lane; k < K; k += 64) s += bf2f(a[k]) * bf2f(b[k]); return wave_sum(s); }
__device__ __forceinline__ float wave_max(float v) {
    v = fmaxf(v, __builtin_bit_cast(float, __builtin_amdgcn_ds_swizzle(__builtin_bit_cast(int, v), (1 << 10) | 0x1f)));
    v = fmaxf(v, __builtin_bit_cast(float, __builtin_amdgcn_ds_swizzle(__builtin_bit_cast(int, v), (2 << 10) | 0x1f)));
    v = fmaxf(v, __builtin_bit_cast(float, __builtin_amdgcn_ds_swizzle(__builtin_bit_cast(int, v), (4 << 10) | 0x1f)));
    v = fmaxf(v, __builtin_bit_cast(float, __builtin_amdgcn_ds_swizzle(__builtin_bit_cast(int, v), (8 << 10) | 0x1f)));
    v = fmaxf(v, __builtin_bit_cast(float, __builtin_amdgcn_ds_swizzle(__builtin_bit_cast(int, v), (16 << 10) | 0x1f)));
    float a = v, b = v; asm volatile("s_nop 1\n\tv_permlane32_swap_b32 %0, %1" : "+v"(a), "+v"(b)); return fmaxf(a, b);
}
__device__ __forceinline__ void acc_err(float* E, int i, float d2, float w2, int lane) { if (lane == 0) { atomicAdd(E + 2 * i, d2); atomicAdd(E + 2 * i + 1, w2); } }
#endif
struct Args { const float* in[16]; float* out; unsigned char* ws; };

__global__ void __launch_bounds__(NWAVES * 64, 2) fwd_mega(Args args) {
    extern __shared__ __attribute__((aligned(16))) unsigned char lds_raw[];
    cg::grid_group grid = cg::this_grid();
    LAS unsigned char* lds = (LAS unsigned char*)lds_raw;
#define FRESH() int tid = threadIdx.x; asm volatile("" : "+v"(tid)); const int lane = tid & 63, wave = __builtin_amdgcn_readfirstlane(tid >> 6); const int gw = bid * NWAVES + wave, NGW = G * NWAVES; const int gt = bid * (NWAVES * 64) + tid, NGT = G * NWAVES * 64; (void)lane; (void)gw; (void)NGW; (void)gt; (void)NGT
    const int G = gridDim.x, bid = blockIdx.x;
    volatile LAS unsigned* xb_st = (volatile LAS unsigned*)(lds + 139264);
    if (threadIdx.x == 0) { xb_st[0] = 0u; xb_st[1] = 0u; }
    __syncthreads();
    if (args.ws == nullptr) grid.sync();
    XcdBarrier xbar = xcd_barrier_post((unsigned*)(args.ws + 65536), xb_st);
    unsigned char* ws = args.ws;
#if PROBE
    if (blockIdx.x == 0 && threadIdx.x == 0) ((unsigned long long*)(ws + 8192))[0] = __builtin_amdgcn_s_memrealtime();
#endif
    const float* x = args.in[0]; const float* g_mix = args.in[1]; const float* w_in = args.in[2];
    const float* g_subln = args.in[7]; const float* w_ft = args.in[8]; const float* w_out = args.in[9]; const float* g_ffn = args.in[10];
    const float* w_up = args.in[11]; const float* w_conv = args.in[12]; const float* b_conv = args.in[13]; const float* w_down = args.in[14]; const float* g_final = args.in[15];
    float* out = args.out;
    bf16* WQK = (bf16*)(ws + WS_WQK); bf16* WVAB = (bf16*)(ws + WS_WVAB); bf16* WOUT = (bf16*)(ws + WS_WOUT); bf16* WUP = (bf16*)(ws + WS_WUP); bf16* WDOWN = (bf16*)(ws + WS_WDOWN);
    float* SS1 = (float*)(ws + WS_SS1); float* SS2 = (float*)(ws + WS_SS2); float* HALO = (float*)(ws + WS_HALO);
    bf16* XN = (bf16*)(ws + WS_XN); bf16* QKB = (bf16*)(ws + WS_QK); bf16* VT = (bf16*)(ws + WS_VT); bf16* TA = (bf16*)(ws + WS_T); bf16* TB = (bf16*)(ws + WS_T + 32 * MiB); bf16* DFT = (bf16*)(ws + WS_DFT); float* PBUF = (float*)(ws + WS_PBUF); unsigned* DFLAGS = (unsigned*)(ws + 16384); unsigned* PCNT = (unsigned*)(ws + 32768); unsigned* KSHARED = (unsigned*)(ws + 49152); bf16* TAF = (bf16*)(ws + WS_DFT + 16 * MiB); bf16* TBF = (bf16*)(ws + WS_DFT + 32 * MiB); unsigned* XBAR = (unsigned*)(ws + 65536);
    bf16* MIX = (bf16*)(ws + WS_MIX); bf16* XB2 = (bf16*)(ws + WS_XB2); bf16* GB = (bf16*)(ws + WS_G);

    for (int rep_ = 0; rep_ < REP_P0; ++rep_) {
        FRESH();
#if PROBE
        if (bid == 0 && tid < 128) ((float*)(ws + 4096))[tid] = 0.f;
#endif
        LAS float* tab = (LAS float*)(lds + TAB_OFF);
        if (tid < 128) { tab[tid] = __builtin_amdgcn_cosf((float)tid * (1.0f / 128.0f)); tab[128 + tid] = __builtin_amdgcn_sinf((float)tid * (1.0f / 128.0f)); }
        __syncthreads();
        LAS float* scr = (LAS float*)(lds + wave * 16384);
        constexpr int I_QK = 32 * 16, I_V = 16 * 16, I_UP = 176 * 16, I_DN = 32 * 44, I_O = 32 * 8;
        constexpr int NITEMS = I_QK + I_V + I_UP + I_DN + I_O;
        for (int rr_ = 0; rr_ < REP_P0A; ++rr_)
        for (int it = gw; it < NITEMS; it += NGW) {
            int r = it;
            if (r < I_QK) { const int nb = r % 32, kb = r / 32; tr_item(w_in, 2048, 64 * kb, 32 * nb, g_mix, nb < 16 ? 0.125f * 1.4426950408889634f : 1.0f, WQK, 1024, 32 * nb, scr, lane); continue; } r -= I_QK;
            if (r < I_V) { const int nb = r % 16, kb = r / 16; tr_item(w_in, 2048, 64 * kb, 1024 + 32 * nb, g_mix, 1.0f, WVAB, 1024, 32 * nb, scr, lane); continue; } r -= I_V;
            if (r < I_UP) { const int nb = r % 176, kb = r / 176; const int pn = nb >> 3, lb = nb & 7; const int sc = lb < 4 ? 128 * pn + 32 * lb : DFF + 128 * pn + 32 * (lb - 4);
                tr_item(w_up, NUP, 64 * kb, sc, g_ffn, 1.0f, WUP, 1024, 32 * nb, scr, lane); continue; } r -= I_UP;
            if (r < I_DN) { const int nb = r % 32, kb = r / 32; tr_item(w_down, 1024, 64 * kb, 32 * nb, nullptr, 1.0f, WDOWN, DFF, 32 * nb, scr, lane); continue; } r -= I_DN;
            { const int nb = r % 32, kb = r / 32; tr_item(w_out, 1024, 64 * kb, 32 * nb, nullptr, 1.0f, WOUT, 1024, 32 * nb, scr, lane); }
        }
        for (int e0 = gt; e0 < 1024 * 4 * 128; e0 += 4 * NGT) { const int c2 = e0 & 127, gi = (e0 >> 7) & 3; int kx[4]; const float* wr_[4]; float ac[4], as[4];
#pragma unroll
            for (int q = 0; q < 4; ++q) { const int e = e0 + q * NGT; kx[q] = (e < 1024 * 4 * 128 ? e : e0) >> 9; wr_[q] = w_in + (size_t)kx[q] * 2048 + 1536 + gi * 128; ac[q] = 0.f; as[q] = 0.f; }
#pragma unroll 4
            for (int c = 0; c < 128; ++c) { const int ix = (c * c2) & 127; const float tc = tab[ix], ts = tab[128 + ix];
#pragma unroll
                for (int q = 0; q < 4; ++q) { const float w = wr_[q][c]; ac[q] += w * tc; as[q] += w * ts; } }
#pragma unroll
            for (int q = 0; q < 4; ++q) if (e0 + q * NGT < 1024 * 4 * 128) { const float sc = g_mix[kx[q]] * 0.08838834764831845f;
                WVAB[(size_t)(512 + gi * 128 + c2) * 1024 + kx[q]] = (bf16)f2bf(ac[q] * sc); WVAB[(size_t)(1024 + gi * 128 + c2) * 1024 + kx[q]] = (bf16)f2bf(as[q] * sc); } }
        for (int e0 = gt; e0 < 512 * 1024; e0 += 4 * NGT) { const int n = e0 & 1023; int kc[4]; const float* wf[4]; const float* wo[4]; float a[4];
#pragma unroll
            for (int q = 0; q < 4; ++q) { const int e = e0 + q * NGT; kc[q] = (e < 512 * 1024 ? e : e0) >> 10; wf[q] = w_ft + (size_t)kc[q] * 128; wo[q] = w_out + (size_t)(512 + (kc[q] >> 7) * 128) * 1024 + n; a[q] = 0.f; }
#pragma unroll 4
            for (int d = 0; d < 128; ++d)
#pragma unroll
                for (int q = 0; q < 4; ++q) a[q] += wf[q][d] * wo[q][(size_t)d * 1024];
#pragma unroll
            for (int q = 0; q < 4; ++q) if (e0 + q * NGT < 512 * 1024) WOUT[(size_t)n * 1024 + 512 + kc[q]] = (bf16)f2bf(a[q]); }
        for (int rr_ = 0; rr_ < REP_P0B; ++rr_)
        for (int e = gt; e < 4096 * 256; e += NGT) { const int r = e >> 8, k8 = (e & 255) * 8; const bool isS = r >= 2048; const int sp = r & 2047; unsigned w[4];
#pragma unroll
            for (int j = 0; j < 4; ++j) { float v[2];
#pragma unroll
                for (int q = 0; q < 2; ++q) { const float ph = (float)((sp * (k8 + 2 * j + q)) & 4095) * (1.0f / 4096.0f); v[q] = isS ? __builtin_amdgcn_sinf(ph) : __builtin_amdgcn_cosf(ph); }
                w[j] = pk2(v[0], v[1]); }
            *(v4u*)(DFT + (size_t)r * 2048 + k8) = (v4u){w[0], w[1], w[2], w[3]}; }
        for (int rr_ = 0; rr_ < REP_P0C; ++rr_)
        for (int m0 = gw * 4; m0 < MTOK; m0 += NGW * 4) {
            f32x4 v[4][4]; float s[4];
#pragma unroll
            for (int r = 0; r < 4; ++r) { const f32x4* xr = (const f32x4*)(x + (size_t)(m0 + r) * DM) + lane;
#pragma unroll
                for (int j = 0; j < 4; ++j) v[r][j] = xr[64 * j]; }
#pragma unroll
            for (int r = 0; r < 4; ++r) { s[r] = 0.f;
#pragma unroll
                for (int j = 0; j < 4; ++j) s[r] += (v[r][j].x * v[r][j].x + v[r][j].y * v[r][j].y) + (v[r][j].z * v[r][j].z + v[r][j].w * v[r][j].w); }
#pragma unroll
            for (int r = 0; r < 4; ++r) { const float rstd = __builtin_amdgcn_rsqf(wave_sum(s[r]) * (1.0f / DM) + 1e-6f); unsigned long long* o8 = (unsigned long long*)(XN + (size_t)(m0 + r) * DM) + lane;
#pragma unroll
                for (int j = 0; j < 4; ++j) o8[64 * j] = (unsigned long long)pk2(v[r][j].x * rstd, v[r][j].y * rstd) | ((unsigned long long)pk2(v[r][j].z * rstd, v[r][j].w * rstd) << 32); } }
    }
    xcd_barrier(xbar);
#if PROBE
    if (blockIdx.x == 0 && threadIdx.x == 0) ((unsigned long long*)(ws + 8192))[1] = __builtin_amdgcn_s_memrealtime();
#endif
#ifdef EXTRA_SYNCS
    for (int q_ = 0; q_ < EXTRA_SYNCS; ++q_) grid.sync();
#endif
    for (int rep_ = 0; rep_ < REP_P1; ++rep_) {
        { pg8::Gemm g{XN, WQK, MTOK, 1024, 1024}; pg8::StaticOrder S; S.init(MTOK, 1024, G, bid); pg8::EpiStore E{QKB, nullptr, nullptr, 1024, 1.0f, 0};
          pg8::gemm_phase<pg8::EpiStore, pg8::StaticOrder, true, true, false>(lds, g, S, E); }
        { pg8::Gemm g{WVAB, XN, 1536, MTOK, 1024}; pg8::StaticOrder S; S.init(1536, MTOK, G, bid); pg8::EpiStore E{VT, TA, TB, 0, 1.0f, 2};
          pg8::gemm_phase<pg8::EpiStore, pg8::StaticOrder, true, true, false>(lds, g, S, E); }
    }
    xcd_barrier(xbar);
#if PROBE
    if (blockIdx.x == 0 && threadIdx.x == 0) ((unsigned long long*)(ws + 8192))[2] = __builtin_amdgcn_s_memrealtime();
#endif
    {
        FRESH();
        const float* lq1 = args.in[3]; const float* lk1 = args.in[4]; const float* lq2 = args.in[5]; const float* lk2 = args.in[6];
        const float d1 = wave_sum(lq1[lane] * lk1[lane]), d2 = wave_sum(lq2[lane] * lk2[lane]);
        const float lam = __expf(d1) - __expf(d2) + 0.2f;
        for (int e = gt; e < 4096 * 256 * 2; e += NGT) { const int which = e >> 20, n = (e >> 8) & 4095, k8 = (e & 255) * 8; const bf16* src = (which ? TB : TA) + (size_t)n * 4096; bf16* dst = (which ? TBF : TAF) + (size_t)n * 2048 + k8;
            typedef unsigned short us8 __attribute__((ext_vector_type(8)));
            const us8 fw = *(const us8*)(src + k8), mr = *(const us8*)(src + 4096 - k8 - 8); const unsigned short m0 = k8 ? src[4096 - k8] : (unsigned short)0;
            const float sgn = which ? -1.0f : 1.0f; unsigned w[4];
#pragma unroll
            for (int jp = 0; jp < 4; ++jp) { float o2[2];
#pragma unroll
                for (int q = 0; q < 2; ++q) { const int jj = 2 * jp + q; const float a = __builtin_bit_cast(float, (unsigned)fw[jj] << 16);
                    const float am = __builtin_bit_cast(float, (unsigned)(jj == 0 ? m0 : mr[(8 - jj) & 7]) << 16);
                    o2[q] = (which && k8 + jj == 0) ? 0.f : a + sgn * am; }
                w[jp] = pk2(o2[0], o2[1]); }
            *(v4u*)dst = (v4u){w[0], w[1], w[2], w[3]}; }
        asm volatile("s_waitcnt vmcnt(0)\n\ts_barrier" ::: "memory");
        if (tid == 0) { __builtin_amdgcn_fence(__ATOMIC_RELEASE, "agent"); asm volatile("s_waitcnt vmcnt(0)" ::: "memory"); __hip_atomic_fetch_add(KSHARED + 103, 1u, __ATOMIC_RELAXED, __HIP_MEMORY_SCOPE_AGENT); }
        if (G == 256) att::kmax_slice(lds, QKB, KSHARED, bid >> 3, bid & 7);
        for (int rep_ = 0; rep_ < REP_ATT; ++rep_)
        if (G == 256) {
            volatile LAS int* qslot = (volatile LAS int*)(lds + 139264 + 64);
            for (;;) {
                if (tid == 0) qslot[0] = (int)__hip_atomic_fetch_add(KSHARED + 100, 1u, __ATOMIC_RELAXED, __HIP_MEMORY_SCOPE_AGENT);
                asm volatile("s_waitcnt vmcnt(0) lgkmcnt(0)\n\ts_barrier" ::: "memory");
                const int uq = __builtin_amdgcn_readfirstlane(qslot[0]);
                asm volatile("s_waitcnt lgkmcnt(0)\n\ts_barrier" ::: "memory");
                if (uq >= 512) break;
                const int hh = 3 - (uq >> 7), jj = uq & 127, rk = jj & 15;
                const int qbq = (rk & 1) ? 8 + (rk >> 1) : 7 - (rk >> 1);
                att::attn_unit(lds, QKB, VT, MIX, g_subln, lam, jj >> 4, hh, qbq, KSHARED);
            }
        } else
        for (int uix = bid; uix < 512; uix += G) { const int bh = uix >> 4, qb = uix & 15; att::attn_unit(lds, QKB, VT, MIX, g_subln, lam, bh >> 2, bh & 3, qb, nullptr); }
        asm volatile("s_waitcnt vmcnt(0) lgkmcnt(0)\n\ts_barrier" ::: "memory");
        for (int n = gw; n < 4096; n += NGW) { const bf16* ar = TA + (size_t)n * 4096; float sacc = 0.f;
            for (int i = 0; i < 8; ++i) { const v4u w = *(const v4u*)(ar + (i * 64 + lane) * 8);
#pragma unroll
                for (int j = 0; j < 4; ++j) { const unsigned ww = j == 0 ? w.x : j == 1 ? w.y : j == 2 ? w.z : w.w; sacc += __builtin_bit_cast(float, ww << 16) - __builtin_bit_cast(float, ww & 0xffff0000u); } }
            sacc = wave_sum(sacc);
            if (lane == 0) MIX[(size_t)((n >> 9) * 4096 + 2048) * 1024 + 512 + (n & 511)] = (bf16)f2bf(sacc * (ABL_FT / 64.0f)); }
        for (unsigned sp = 0; sp < (1u << 22); ++sp) { if (__hip_atomic_load(KSHARED + 103, __ATOMIC_RELAXED, __HIP_MEMORY_SCOPE_AGENT) >= (unsigned)G) break; __builtin_amdgcn_s_sleep(4); }
        __builtin_amdgcn_fence(__ATOMIC_ACQUIRE, "agent"); asm volatile("s_waitcnt vmcnt(0)\n\ts_barrier" ::: "memory");
        { pg8::Gemm g{DFT, TAF, 4096, 4096, 2048, TBF, 8}; pg8::DftOrder S{G, bid}; pg8::EpiDft E{PBUF, DFLAGS, MIX, ABL_FT / 64.0f, TA};
          pg8::gemm_phase<pg8::EpiDft, pg8::DftOrder, true, true, false>(lds, g, S, E); }
    }
    xcd_barrier(xbar);
#if PROBE
    if (blockIdx.x == 0 && threadIdx.x == 0) ((unsigned long long*)(ws + 8192))[3] = __builtin_amdgcn_s_memrealtime();
#endif

#if PROBE && PROBE < 50
    {
        FRESH(); float* E = (float*)(ws + 4096);
        for (int s = 0; s < 2; ++s) { const unsigned id = hash32((unsigned)(gw * 2 + s) + 12345u); const int tok = id & 32767, col = (id >> 15) & 1023;
            const float want = wdot_bf(XN + (size_t)tok * 1024, WQK + (size_t)col * 1024, 1024, lane), got = bf2f(QKB[(size_t)tok * 1024 + col]); acc_err(E, 0, (got - want) * (got - want), want * want, lane);  acc_err(E, 6, got * want, want * want, lane);
            float wh; { float s_ = 0.f; for (int k = lane; k < 1024; k += 64) if (((k >> 6) & 1) == 0) s_ += bf2f(XN[(size_t)tok * 1024 + k]) * bf2f(WQK[(size_t)col * 1024 + k]); wh = wave_sum(s_); } acc_err(E, 7, (got - wh) * (got - wh), wh * wh, lane);
            const float wh2 = want - wh; acc_err(E, 8, (got - wh2) * (got - wh2), wh2 * wh2, lane);
            { const float bad = fabsf(got - want) > 0.1f * fabsf(want) + 0.02f ? 1.f : 0.f; const int hb[6] = {(tok >> 6) & 1, (tok >> 7) & 1, (col >> 7) & 1, (tok >> 4) & 1, (col >> 5) & 1, (tok >> 8) & 1};
              for (int h = 0; h < 6; ++h) acc_err(E, 10 + 2 * h + (hb[h] ? 0 : 1), bad, 1.f, lane); } }
        for (int s = 0; s < 2; ++s) { const unsigned id = hash32((unsigned)(gw * 2 + s) + 4711u); const int tok = id & 32767, col = (id >> 15) & 1023;
            const int k = lane * 16 + (id >> 25) % 16; const float wsrc = w_in[(size_t)k * 2048 + col] * g_mix[k] * (col < 512 ? 0.125f * 1.4426950408889634f : 1.0f), wgot = bf2f(WQK[(size_t)col * 1024 + k]);
            float ssq = 0.f; for (int kk = lane; kk < 1024; kk += 64) { const float xv = x[(size_t)tok * 1024 + kk]; ssq += xv * xv; } const float rstd = rsqrtf(wave_sum(ssq) * (1.0f / 1024.0f) + 1e-6f);
            const float xsrc = x[(size_t)tok * 1024 + k] * rstd, xgot = bf2f(XN[(size_t)tok * 1024 + k]);
            acc_err(E, 9, wave_sum((wgot - wsrc) * (wgot - wsrc)), wave_sum(wsrc * wsrc), lane); acc_err(E, 22, wave_sum((xgot - xsrc) * (xgot - xsrc)), wave_sum(xsrc * xsrc), lane); }
        for (int s = 0; s < 2; ++s) { const unsigned id = hash32((unsigned)(gw * 2 + s) + 777u); const int tok = id & 32767, n = (id >> 15) % 1536; const int b = tok >> 12, sq = tok & 4095;
            const float want = wdot_bf(WVAB + (size_t)n * 1024, XN + (size_t)tok * 1024, 1024, lane);
            const float got = n < 512 ? bf2f(VT[(size_t)(b * 512 + n) * 4096 + sq]) : n < 1024 ? bf2f(TB[(size_t)(b * 512 + n - 512) * 8192 + sq]) : bf2f(TB[(size_t)(b * 512 + n - 1024) * 8192 + 4096 + sq]);
            acc_err(E, 1, (got - want) * (got - want), want * want, lane); }
        { const unsigned id = hash32((unsigned)gw + 999u); const int b = id & 7, sp = (id >> 3) & 4095, c2 = (id >> 15) & 511;
            const float want = wdot_bf(DFT + (size_t)sp * 8192, TB + (size_t)(b * 512 + c2) * 8192, 8192, lane) * (1.0f / 64.0f), got = bf2f(MIX[(size_t)(b * 4096 + sp) * 1024 + 512 + c2]);
            acc_err(E, 3, (got - want) * (got - want), want * want, lane); }
        {
            const unsigned id = hash32((unsigned)gw + 4242u); const int b = id & 7, h = (id >> 3) & 3, q = (id >> 5) & 4095;
            const float* lq1 = args.in[3]; const float* lk1 = args.in[4]; const float* lq2 = args.in[5]; const float* lk2 = args.in[6];
            const float lam = __expf(wave_sum(lq1[lane] * lk1[lane])) - __expf(wave_sum(lq2[lane] * lk2[lane])) + 0.2f;
            const float slope2 = exp2f(-2.0f * (float)(h + 1)) * 1.4426950408889634f;
            const bf16* Qp = QKB + (size_t)(b * 4096 + q) * 1024 + h * 128; LAS float* av = (LAS float*)(lds + wave * 16384);
            float m0 = -1e30f, m1 = -1e30f, l0 = 0.f, l1 = 0.f;
            for (int kv = lane; kv < 4096; kv += 64) { const bf16* Kp = QKB + (size_t)(b * 4096 + kv) * 1024 + 512 + h * 128; float s0 = 0.f, s1 = 0.f;
                for (int d = 0; d < 64; ++d) { s0 += bf2f(Qp[d]) * bf2f(Kp[d]); s1 += bf2f(Qp[64 + d]) * bf2f(Kp[64 + d]); }
                const float bias = slope2 * fabsf((float)(q - kv)); s0 -= bias; s1 -= bias;
                { const float mn = fmaxf(m0, s0); l0 = l0 * exp2f(m0 - mn) + exp2f(s0 - mn); m0 = mn; } { const float mn = fmaxf(m1, s1); l1 = l1 * exp2f(m1 - mn) + exp2f(s1 - mn); m1 = mn; } }
            const float M0 = wave_max(m0), M1 = wave_max(m1); const float L0 = wave_sum(l0 * exp2f(m0 - M0)), L1 = wave_sum(l1 * exp2f(m1 - M1));
            for (int kv = lane; kv < 4096; kv += 64) { const bf16* Kp = QKB + (size_t)(b * 4096 + kv) * 1024 + 512 + h * 128; float s0 = 0.f, s1 = 0.f;
                for (int d = 0; d < 64; ++d) { s0 += bf2f(Qp[d]) * bf2f(Kp[d]); s1 += bf2f(Qp[64 + d]) * bf2f(Kp[64 + d]); }
                const float bias = slope2 * fabsf((float)(q - kv)); s0 -= bias; s1 -= bias;
                av[kv] = exp2f(s0 - M0) / L0 - lam * exp2f(s1 - M1) / L1; }
            asm volatile("s_waitcnt lgkmcnt(0)" ::: "memory");
            float o[2];
            for (int i = 0; i < 2; ++i) { const bf16* Vp = VT + (size_t)(b * 512 + h * 128 + lane + 64 * i) * 4096; float a = 0.f; for (int kv = 0; kv < 4096; ++kv) a += av[kv] * bf2f(Vp[kv]); o[i] = a; }
            const float rn = rsqrtf(wave_sum(o[0] * o[0] + o[1] * o[1]) * (1.0f / 128.0f) + 1e-5f) * 0.8f; float d2 = 0.f, w2 = 0.f;
            for (int i = 0; i < 2; ++i) { const float want = o[i] * rn * g_subln[lane + 64 * i], got = bf2f(MIX[(size_t)(b * 4096 + q) * 1024 + h * 128 + lane + 64 * i]); d2 += (got - want) * (got - want); w2 += want * want; }
            acc_err(E, 2, wave_sum(d2), wave_sum(w2), lane);
            asm volatile("s_waitcnt lgkmcnt(0)\n\ts_barrier" ::: "memory");
        }
    }
#endif
#ifdef EXTRA_XB
    _Pragma("unroll 1") for (int q_ = 0; q_ < EXTRA_XB; ++q_) { asm volatile("" ::: "memory"); xcd_barrier(xbar); }
#endif
    for (int rep_ = 0; rep_ < REP_P3; ++rep_)
    { pg8::Gemm g{MIX, WOUT, MTOK, 1024, 1024}; pg8::StaticOrder S; S.init(MTOK, 1024, G, bid); pg8::EpiRes E{x, nullptr, nullptr, XB2, SS1, 1.0f};
      pg8::gemm_phase<pg8::EpiRes, pg8::StaticOrder, true, true, false>(lds, g, S, E); }
    xcd_barrier(xbar);
#if PROBE
    if (blockIdx.x == 0 && threadIdx.x == 0) ((unsigned long long*)(ws + 8192))[4] = __builtin_amdgcn_s_memrealtime();
#endif

#if PROBE && PROBE < 50
    {
        FRESH(); float* E = (float*)(ws + 4096);
        for (int s = 0; s < 2; ++s) { const unsigned id = hash32((unsigned)(gw * 2 + s) + 31337u); const int tok = id & 32767, n = (id >> 15) & 1023;
            const float want = x[(size_t)tok * 1024 + n] + wdot_bf(MIX + (size_t)tok * 1024, WOUT + (size_t)n * 1024, 1024, lane), got = out[(size_t)tok * 1024 + n]; acc_err(E, 4, (got - want) * (got - want), want * want, lane); }
    }
#endif
    for (int rep_ = 0; rep_ < REP_P4; ++rep_)
    { pg8::Gemm g{XB2, WUP, MTOK, NUP, 1024}; pg8::StaticOrder S; S.init(MTOK, NUP, G, bid); pg8::EpiConv E{SS1, w_conv, b_conv, GB, HALO, (LAS float*)(lds + XCH_OFF)};
      pg8::gemm_phase<pg8::EpiConv, pg8::StaticOrder, true, true, true>(lds, g, S, E); }
    xcd_barrier(xbar);
#if PROBE
    if (blockIdx.x == 0 && threadIdx.x == 0) ((unsigned long long*)(ws + 8192))[5] = __builtin_amdgcn_s_memrealtime();
#endif
    { FRESH();
    for (int e = gt; e < 128 * 2 * (DFF / 4); e += NGT) { const int j4 = (e % (DFF / 4)) * 4, pw = e / (DFF / 4), pm = pw >> 1, which = pw & 1; const int pn = j4 >> 7, lc = j4 & 127;
        const float* h0 = HALO + (size_t)pm * 4 * NUP + pn * 256 + lc; f32x4 cv[2];
#pragma unroll
        for (int bj = 0; bj < 2; ++bj) { const float* hb = h0 + bj * 128; f32x4 up, cu, dn; const f32x4 z = (f32x4){0.f, 0.f, 0.f, 0.f};
            if (which == 0) { up = (pm & 15) ? *(const f32x4*)(hb - (size_t)4 * NUP + (size_t)3 * NUP) : z; cu = *(const f32x4*)(hb); dn = *(const f32x4*)(hb + NUP); }
            else { up = *(const f32x4*)(hb + (size_t)2 * NUP); cu = *(const f32x4*)(hb + (size_t)3 * NUP); dn = ((pm & 15) != 15) ? *(const f32x4*)(hb + (size_t)4 * NUP) : z; }
            const int jc = j4 + bj * DFF; cv[bj] = *(const f32x4*)(w_conv + jc) * up + *(const f32x4*)(w_conv + NUP + jc) * cu + *(const f32x4*)(w_conv + 2 * NUP + jc) * dn + *(const f32x4*)(b_conv + jc); }
        float r[4];
#pragma unroll
        for (int q = 0; q < 4; ++q) { const float gg = cv[0][q]; r[q] = gg * __builtin_amdgcn_rcpf(1.0f + __builtin_amdgcn_exp2f(-1.4426950408889634f * gg)) * cv[1][q]; }
        *(unsigned long long*)(GB + (size_t)(pm * 256 + (which ? 255 : 0)) * DFF + j4) = (unsigned long long)pk2(r[0], r[1]) | ((unsigned long long)pk2(r[2], r[3]) << 32); } }
    xcd_barrier(xbar);
#if PROBE
    if (blockIdx.x == 0 && threadIdx.x == 0) ((unsigned long long*)(ws + 8192))[6] = __builtin_amdgcn_s_memrealtime();
#endif

#if PROBE && PROBE < 50
    {
        FRESH(); float* E = (float*)(ws + 4096);
        for (int s = 0; s < 2; ++s) { const unsigned id = hash32((unsigned)(gw * 2 + s) + 55555u); int tok = id & 32767; const int j = (id >> 15) % DFF; const int md = (id >> 28) & 7;
            if (md == 1) tok = (tok & ~255) + 7; if (md == 2) tok = (tok & ~255) + 8; if (md == 3) tok = (tok & ~255) + 63; if (md == 4) tok = (tok & ~255) + 3; if (md == 5) tok = (tok & ~255) + 64;
            const int rowg = (j >> 7) * 256 + (j & 127); float cg = b_conv[j], cv = b_conv[DFF + j];
            for (int d = -1; d <= 1; ++d) { const int r = tok + d; if ((r >> 12) != (tok >> 12) || r < 0) continue;
                float ssum = 0.f; for (int i = 0; i < 16; ++i) ssum += SS1[(size_t)r * 16 + i]; const float rstd = rsqrtf(ssum * (1.0f / 1024.0f) + 1e-6f);
                const float ug = rstd * wdot_bf(XB2 + (size_t)r * 1024, WUP + (size_t)rowg * 1024, 1024, lane), uv = rstd * wdot_bf(XB2 + (size_t)r * 1024, WUP + (size_t)(rowg + 128) * 1024, 1024, lane);
                cg += w_conv[(size_t)(d + 1) * NUP + j] * ug; cv += w_conv[(size_t)(d + 1) * NUP + DFF + j] * uv; }
            const float want = cg / (1.0f + __expf(-cg)) * cv, got = bf2f(GB[(size_t)tok * DFF + j]); acc_err(E, 5, (got - want) * (got - want), want * want, lane); acc_err(E, 40 + (md > 5 ? 0 : md), (got - want) * (got - want), want * want, lane); }
    }
    xcd_barrier(xbar);
#endif
    for (int rep5_ = 0; rep5_ < REP_P5; ++rep5_)
    if (G == 256 && !FORCE_UNFUSED) {
      pg8::Gemm g{GB, WDOWN, MTOK, 1024, DFF}; pg8::StaticOrder S; S.init(MTOK, 1024, G, bid); pg8::EpiResNorm E{XB2, out, SS2, PCNT, g_final, ABL_FFN, 1u};
      pg8::gemm_phase<pg8::EpiResNorm, pg8::StaticOrder, P5_ALIGN, P5_SP2, false>(lds, g, S, E);
    } else {
    { pg8::Gemm g{GB, WDOWN, MTOK, 1024, DFF}; pg8::StaticOrder S; S.init(MTOK, 1024, G, bid); pg8::EpiRes E{nullptr, XB2, out, nullptr, SS2, ABL_FFN};
      pg8::gemm_phase<pg8::EpiRes, pg8::StaticOrder, true, true, false>(lds, g, S, E); }
    xcd_barrier(xbar);
    { FRESH();
    for (int m = gw; m < MTOK; m += NGW) { f32x4* xr = (f32x4*)(out + (size_t)m * DM) + lane; const float sp = lane < 16 ? SS2[(size_t)m * 16 + lane] : 0.f;
        const float rstd = __builtin_amdgcn_rsqf(wave_sum(sp) * (1.0f / DM) + 1e-6f);
#pragma unroll
        for (int j = 0; j < 4; ++j) { const f32x4 gf = ((const f32x4*)g_final)[lane + 64 * j]; const f32x4 v = xr[64 * j]; xr[64 * j] = v * rstd * gf; } } }
    }

#if PROBE
    xcd_barrier(xbar);
    { FRESH(); const float* E = (const float*)(ws + 4096); float code;
      if (PROBE == 2) { int mask = 0; for (int h = 0; h < 6; ++h) { const float f1 = E[2 * (10 + 2 * h)] / E[2 * (10 + 2 * h) + 1], f0 = E[2 * (11 + 2 * h)] / E[2 * (11 + 2 * h) + 1]; if (f1 > 0.8f && f0 < 0.2f) mask |= 1 << h; } code = (float)mask; }
      else if (PROBE == 3) { int mask = 0; for (int h = 0; h < 6; ++h) { const float f1 = E[2 * (10 + 2 * h)] / E[2 * (10 + 2 * h) + 1], f0 = E[2 * (11 + 2 * h)] / E[2 * (11 + 2 * h) + 1]; if (f0 > 0.8f && f1 < 0.2f) mask |= 1 << h; } code = (float)mask; }
      else if (PROBE == 4) { int mask = 0; const float fl = (float)lane;
          if (pg8::xsum<1>(fl) != (float)(lane + (lane ^ 1))) mask |= 1; if (pg8::xsum<2>(fl) != (float)(lane + (lane ^ 2))) mask |= 2; if (pg8::xsum<4>(fl) != (float)(lane + (lane ^ 4))) mask |= 4;
          if (pg8::xsum<8>(fl) != (float)(lane + (lane ^ 8))) mask |= 8; if (pg8::xsum<16>(fl) != (float)(lane + (lane ^ 16))) mask |= 16; if (pg8::xsum<32>(fl) != (float)(lane + (lane ^ 32))) mask |= 32;
          mask = __any(mask & 1) * 1 + __any(mask & 2) * 2 + __any(mask & 4) * 4 + __any(mask & 8) * 8 + __any(mask & 16) * 16 + __any(mask & 32) * 32; code = (float)mask; }
      else if (PROBE == 5) { int mask = 0; for (int i = 0; i < 6; ++i) if (!(E[2 * (40 + i)] <= 3e-3f * E[2 * (40 + i) + 1])) mask |= 1 << i; code = (float)mask; }
      else if (PROBE == 6) { int mask = 0; const int fr = lane & 15;
          const int a = __builtin_amdgcn_update_dpp(0, lane + 100, 0x111, 0xf, 0xf, true), b = __builtin_amdgcn_update_dpp(0, lane + 100, 0x101, 0xf, 0xf, true);
          if (a != (fr == 0 ? 0 : lane + 99)) mask |= 1; if (b != (fr == 15 ? 0 : lane + 101)) mask |= 2; if (a == (fr == 15 ? 0 : lane + 101)) mask |= 4; if (b == (fr == 0 ? 0 : lane + 99)) mask |= 8;
          mask = __any(mask & 1) * 1 + __any(mask & 2) * 2 + __all(mask & 4) * 4 + __all(mask & 8) * 8; code = (float)mask; }
      else if (PROBE >= 50 && PROBE < 60) { const unsigned long long* ts = (const unsigned long long*)(ws + 8192); code = (float)(ts[PROBE - 50 + 1] - ts[PROBE - 50]) * 0.01f; }
      else if (PROBE == 1) { int mask = 0; for (int i = 0; i < 6; ++i) if (!(E[2 * i] <= 3e-3f * E[2 * i + 1])) mask |= 1 << i; code = (float)mask; }
      else { const int i = PROBE - 10; code = 1e6f * E[2 * i] / E[2 * i + 1]; }
      const float kk = sqrtf(code);
      for (int e = gt; e < MTOK * DM / 4; e += NGT) ((f32x4*)out)[e] = (f32x4){kk, kk, kk, kk}; }
#endif
}

extern "C" void kernel_launch(void* const* d_in, const int* in_sizes, int n_in, void* d_out, int out_size, void* d_ws, size_t ws_size, hipStream_t stream) {
    static int grid = 0;
    if (grid == 0) {
        if (n_in != 16 || out_size != MTOK * DM || ws_size < WS_END) { fprintf(stderr, "kernel_launch: unexpected shapes (n_in %d out %d ws %zu)\n", n_in, out_size, ws_size); grid = -1; return; }
        int dev = 0, cus = 0, per_cu = 0;
        hipGetDevice(&dev); hipDeviceGetAttribute(&cus, hipDeviceAttributeMultiprocessorCount, dev);
        hipFuncSetAttribute((const void*)fwd_mega, hipFuncAttributeMaxDynamicSharedMemorySize, LDS_BYTES);
        hipOccupancyMaxActiveBlocksPerMultiprocessor(&per_cu, (const void*)fwd_mega, NWAVES * 64, LDS_BYTES);
        if (per_cu < 1) { fprintf(stderr, "kernel_launch: occupancy query says %d blocks per CU\n", per_cu); per_cu = 1; }
        (void)hipGetLastError();
        grid = cus;
    }
    if (grid < 0) return;
    if (hipMemsetAsync(d_ws, 0, 131072, stream) != hipSuccess) { fprintf(stderr, "kernel_launch: hipMemsetAsync of the control words failed\n"); return; }
    Args a{};
    for (int i = 0; i < 16; ++i) a.in[i] = (const float*)d_in[i];
    a.out = (float*)d_out; a.ws = (unsigned char*)d_ws;
    void* kargs[] = {&a};
    hipError_t e = hipLaunchCooperativeKernel((const void*)fwd_mega, dim3(grid), dim3(NWAVES * 64), kargs, LDS_BYTES, stream);
    if (e != hipSuccess) fprintf(stderr, "cooperative launch failed: %s (grid %d)\n", hipGetErrorString(e), grid);
}
```
